# Optimizing an MI355X kernel written in HIP

```python
import math
import numpy as np
import jax
import jax.numpy as jnp
from jax import lax

D_MODEL = 2048
BATCH = 2
SEQ = 16384
DEPTH = 2

GRID_W = 64
HY_W = 512
HY_ORDER = 2
HY_BANDS = 16
HY_EMB = 1 + 2 * HY_BANDS
HY_FFN = 64
HY_DECAY_TARGET = 1e-2
HY_FAST_DECAY = 0.3
HY_SLOW_DECAY = 1.5
NA_HEADS = 8
NA_HEAD_DIM = 64
NA_W = NA_HEADS * NA_HEAD_DIM
NA_WIN_R = 8
NA_WIN_C = 16
MLA_HEADS = 8
MLA_Q_RANK = 512
MLA_KV_RANK = 256
MLA_NOPE = 128
MLA_ROPE = 64
MLA_V = 128
MLA_W = MLA_HEADS * MLA_V
ROPE_BASE = 10000.0
Q_BLOCK = 128
MIX_W = HY_W + NA_W + MLA_W
IN_W = 3 * HY_W + 3 * NA_W + MLA_Q_RANK + MLA_KV_RANK + MLA_ROPE
N_EXPERTS = 64
N_GROUPS = 8
TOP_K = 2
D_EXPERT = 512
MOE_BLOCK = 128
ALPHA = (2 * DEPTH) ** 0.25
BETA = (8 * DEPTH) ** -0.25
EPS = 1e-5

kernel_name = 'hybrid_hyena_natten_mla_moe_encoder'

F32 = jnp.float32


def layer_norm(x, g, b):
    xf = x.astype(F32)
    mu = jnp.mean(xf, -1, keepdims=True)
    var = jnp.mean(jnp.square(xf - mu), -1, keepdims=True)
    return ((xf - mu) * lax.rsqrt(var + EPS) * g.astype(F32) + b.astype(F32)).astype(x.dtype)


def rms_norm(x, g):
    xf = x.astype(F32)
    return (xf * lax.rsqrt(jnp.mean(xf * xf, -1, keepdims=True) + EPS) * g.astype(F32)).astype(x.dtype)


def rope(x, cos, sin):
    x1, x2 = jnp.split(x, 2, axis=-1)
    return jnp.concatenate([x1 * cos - x2 * sin, x1 * sin + x2 * cos], -1).astype(x.dtype)


def hyena_filter_spectra(L, w1, b1, f1, w2, b2, f2, w3):
    t_idx = jnp.arange(L, dtype=F32)
    t = t_idx / L
    bands = jnp.linspace(1e-4, HY_BANDS - 1, HY_BANDS, dtype=F32)
    ang = (2.0 * math.pi) * t[:, None] * bands[None, :]
    feats = jnp.concatenate([t[:, None], jnp.cos(ang), -jnp.sin(ang)], -1)
    h = jnp.sin(f1.astype(F32) * (feats @ w1.astype(F32) + b1.astype(F32)))
    h = jnp.sin(f2.astype(F32) * (h @ w2.astype(F32) + b2.astype(F32)))
    h = (h @ w3.astype(F32)).reshape(L, 2, HY_ORDER, HY_W)
    deltas = jnp.abs(jnp.linspace(math.log(HY_DECAY_TARGET) / HY_SLOW_DECAY,
                                  math.log(HY_DECAY_TARGET) / HY_FAST_DECAY, HY_W, dtype=F32))
    h = h * jnp.exp(-t[:, None] * deltas[None, :])[:, None, None, :]
    fwd, bwd = h[:, 0], h[:, 1]
    k = jnp.concatenate([fwd, jnp.zeros((1, HY_ORDER, HY_W), F32), jnp.flip(bwd[1:], 0)], 0)
    k = k / jnp.sum(jnp.abs(k), axis=0, keepdims=True)
    return jnp.fft.rfft(k, axis=0)


def hyena_mixer(u, conv_w, conv_b, w1, b1, f1, w2, b2, f2, w3, d_skip):
    L = u.shape[1]
    up = jnp.pad(u, ((0, 0), (1, 1), (0, 0)))
    uc = conv_w[0] * up[:, :-2] + conv_w[1] * up[:, 1:-1] + conv_w[2] * up[:, 2:] + conv_b
    v, x1, x2 = jnp.split(uc, 3, axis=-1)
    kf = hyena_filter_spectra(L, w1, b1, f1, w2, b2, f2, w3)
    z = v
    for o, gate in enumerate((x1, x2)):
        zf = z.astype(F32)
        y = jnp.fft.irfft(jnp.fft.rfft(zf, n=2 * L, axis=1) * kf[:, o], n=2 * L, axis=1)[:, :L]
        z = gate * (y + zf * d_skip[o].astype(F32)).astype(u.dtype)
    return z


def neighbourhood_attention(q, k, v, rpb):
    B, L, _ = q.shape
    rows = L // GRID_W
    wr = min(NA_WIN_R, rows)
    wc = min(NA_WIN_C, GRID_W)
    shp = (B, rows, GRID_W, NA_HEADS, NA_HEAD_DIM)
    q, k, v = q.reshape(shp), k.reshape(shp), v.reshape(shp)
    cols = np.arange(GRID_W)
    col_idx = np.clip(cols - wc // 2, 0, GRID_W - wc)[:, None] + np.arange(wc)[None, :]
    dc_idx = col_idx - cols[:, None] + (NA_WIN_C - 1)
    rpb_c = rpb[:, :, dc_idx].astype(F32)
    scale = NA_HEAD_DIM ** -0.5

    def one_row(r):
        q_r = lax.dynamic_index_in_dim(q, r, axis=1, keepdims=False)
        rs = jnp.clip(r - wr // 2, 0, rows - wr)
        k_g = lax.dynamic_slice_in_dim(k, rs, wr, axis=1)[:, :, col_idx]
        v_g = lax.dynamic_slice_in_dim(v, rs, wr, axis=1)[:, :, col_idx]
        bias = rpb_c[:, rs + jnp.arange(wr) - r + (NA_WIN_R - 1)]
        s = jnp.einsum('bchd,bicjhd->bhcij', q_r, k_g).astype(F32) * scale
        s = s + jnp.transpose(bias, (0, 2, 1, 3))[None]
        p = jax.nn.softmax(s.reshape(B, NA_HEADS, GRID_W, wr * wc), -1).reshape(s.shape)
        return jnp.einsum('bhcij,bicjhd->bchd', p.astype(v.dtype), v_g)

    o = lax.map(one_row, jnp.arange(rows))
    return jnp.swapaxes(o, 0, 1).reshape(B, L, NA_W)


def latent_attention(cq, ckv, k_rope, q_norm_g, w_uq, kv_norm_g, w_ukv):
    B, L, _ = cq.shape
    q = (rms_norm(cq, q_norm_g) @ w_uq).reshape(B, L, MLA_HEADS, MLA_NOPE + MLA_ROPE)
    kv = (rms_norm(ckv, kv_norm_g) @ w_ukv).reshape(B, L, MLA_HEADS, MLA_NOPE + MLA_V)
    q_nope, q_rot = q[..., :MLA_NOPE], q[..., MLA_NOPE:]
    k_nope, v = kv[..., :MLA_NOPE], kv[..., MLA_NOPE:]
    pos = jnp.arange(L, dtype=F32)
    inv_freq = ROPE_BASE ** (-jnp.arange(0, MLA_ROPE, 2, dtype=F32) / MLA_ROPE)
    ang = pos[:, None] * inv_freq[None, :]
    cos, sin = jnp.cos(ang), jnp.sin(ang)
    q_rot = rope(q_rot, cos[:, None, :], sin[:, None, :])
    k_rot = rope(k_rope, cos, sin)
    scale = (MLA_NOPE + MLA_ROPE) ** -0.5
    nb = L // Q_BLOCK

    def to_blocks(t):
        return jnp.swapaxes(t.reshape(B, nb, Q_BLOCK, *t.shape[2:]), 0, 1)

    def attend(blk):
        qn, qr = blk
        s = jnp.einsum('bqhd,bkhd->bhqk', qn, k_nope) + jnp.einsum('bqhd,bkd->bhqk', qr, k_rot)
        p = jax.nn.softmax(s.astype(F32) * scale, -1).astype(v.dtype)
        return jnp.einsum('bhqk,bkhd->bqhd', p, v)

    o = lax.map(attend, (to_blocks(q_nope), to_blocks(q_rot)))
    return jnp.swapaxes(o, 0, 1).reshape(B, L, MLA_W)


def grouped_moe(h, router_w, router_b, w_gate, w_up, w_down):
    T, D = h.shape
    per = N_EXPERTS // N_GROUPS
    scores = jax.nn.sigmoid(h.astype(F32) @ router_w.astype(F32))
    sel = scores + router_b.astype(F32)
    grp = lax.top_k(sel.reshape(T, N_GROUPS, per), 2)[0].sum(-1)
    best = jnp.argmax(grp, -1)
    in_group = (jnp.arange(N_EXPERTS) // per)[None, :] == best[:, None]
    _, idx = lax.top_k(jnp.where(in_group, sel, -jnp.inf), TOP_K)
    gate = jnp.take_along_axis(scores, idx, -1)
    gate = gate / jnp.sum(gate, -1, keepdims=True)
    A = T * TOP_K
    flat_e = idx.reshape(A)
    flat_tok = jnp.arange(A, dtype=jnp.int32) // TOP_K
    flat_w = gate.reshape(A)
    order = jnp.argsort(flat_e)
    se, stok, sw = flat_e[order], flat_tok[order], flat_w[order]
    counts = jnp.bincount(flat_e, length=N_EXPERTS)
    starts = jnp.cumsum(counts) - counts
    padded = (counts + MOE_BLOCK - 1) // MOE_BLOCK * MOE_BLOCK
    pends = jnp.cumsum(padded)
    pstarts = pends - padded
    dest = pstarts[se] + jnp.arange(A, dtype=jnp.int32) - starts[se]
    P = A + N_EXPERTS * MOE_BLOCK
    nblk = P // MOE_BLOCK
    buf_tok = jnp.full((P,), T, jnp.int32).at[dest].set(stok.astype(jnp.int32))
    buf_w = jnp.zeros((P,), F32).at[dest].set(sw)
    blk_e = jnp.minimum(jnp.searchsorted(pends, jnp.arange(nblk) * MOE_BLOCK, side='right'), N_EXPERTS - 1)
    h_pad = jnp.concatenate([h, jnp.zeros((1, D), h.dtype)], 0)
    xb = h_pad[buf_tok].reshape(nblk, MOE_BLOCK, D)

    def expert_block(args):
        xblk, e = args
        return (jax.nn.silu(xblk @ w_gate[e]) * (xblk @ w_up[e])) @ w_down[e]

    yb = lax.map(expert_block, (xb, blk_e)).reshape(P, D)
    out = jax.ops.segment_sum(yb * buf_w[:, None].astype(yb.dtype), buf_tok, num_segments=T + 1)
    return out[:T]


def setup_inputs(seed: int = 0) -> dict:
    key = jax.random.key(seed)
    ks = iter(jax.random.split(key, 40))

    def nrm(shape, scale):
        return jax.random.normal(next(ks), shape, F32) * scale

    def gain(shape):
        return 1.0 + nrm(shape, 0.02)

    return {
        'x': nrm((BATCH, SEQ, D_MODEL), 1.0),
        'w_in': nrm((DEPTH, D_MODEL, IN_W), D_MODEL ** -0.5),
        'conv_w': nrm((DEPTH, 3, 3 * HY_W), 3 ** -0.5),
        'conv_b': nrm((DEPTH, 3 * HY_W), 0.02),
        'hy_w1': nrm((DEPTH, HY_EMB, HY_FFN), HY_EMB ** -0.5),
        'hy_b1': nrm((DEPTH, HY_FFN), 0.1),
        'hy_f1': gain((DEPTH, HY_FFN)),
        'hy_w2': nrm((DEPTH, HY_FFN, HY_FFN), HY_FFN ** -0.5),
        'hy_b2': nrm((DEPTH, HY_FFN), 0.1),
        'hy_f2': gain((DEPTH, HY_FFN)),
        'hy_w3': nrm((DEPTH, HY_FFN, 2 * HY_ORDER * HY_W), HY_FFN ** -0.5),
        'hy_d': nrm((DEPTH, HY_ORDER, HY_W), 0.1),
        'na_rpb': nrm((DEPTH, NA_HEADS, 2 * NA_WIN_R - 1, 2 * NA_WIN_C - 1), 0.05),
        'q_norm_g': gain((DEPTH, MLA_Q_RANK)),
        'w_uq': nrm((DEPTH, MLA_Q_RANK, MLA_HEADS * (MLA_NOPE + MLA_ROPE)), MLA_Q_RANK ** -0.5),
        'kv_norm_g': gain((DEPTH, MLA_KV_RANK)),
        'w_ukv': nrm((DEPTH, MLA_KV_RANK, MLA_HEADS * (MLA_NOPE + MLA_V)), MLA_KV_RANK ** -0.5),
        'grp_norm_g': gain((DEPTH, MIX_W)),
        'w_out': nrm((DEPTH, MIX_W, D_MODEL), MIX_W ** -0.5 * BETA),
        'ln1_g': gain((DEPTH, D_MODEL)),
        'ln1_b': nrm((DEPTH, D_MODEL), 0.02),
        'router_w': nrm((D_MODEL, N_EXPERTS), D_MODEL ** -0.5),
        'router_b': nrm((N_EXPERTS,), 0.01),
        'exp_w_gate': nrm((DEPTH, N_EXPERTS, D_MODEL, D_EXPERT), D_MODEL ** -0.5),
        'exp_w_up': nrm((DEPTH, N_EXPERTS, D_MODEL, D_EXPERT), D_MODEL ** -0.5),
        'exp_w_down': nrm((DEPTH, N_EXPERTS, D_EXPERT, D_MODEL), D_EXPERT ** -0.5 * BETA),
        'ln2_g': gain((DEPTH, D_MODEL)),
        'ln2_b': nrm((DEPTH, D_MODEL), 0.02),
    }


def reference(x, w_in, conv_w, conv_b, hy_w1, hy_b1, hy_f1, hy_w2, hy_b2, hy_f2, hy_w3, hy_d,
              na_rpb, q_norm_g, w_uq, kv_norm_g, w_ukv, grp_norm_g, w_out, ln1_g, ln1_b,
              router_w, router_b, exp_w_gate, exp_w_up, exp_w_down, ln2_g, ln2_b):
    B, L, D = x.shape
    splits = [3 * HY_W, 3 * HY_W + 3 * NA_W, 3 * HY_W + 3 * NA_W + MLA_Q_RANK,
              3 * HY_W + 3 * NA_W + MLA_Q_RANK + MLA_KV_RANK]
    for l in range(DEPTH):
        proj = x @ w_in[l]
        p_hy, p_na, p_cq, p_ckv, p_kr = jnp.split(proj, splits, axis=-1)
        y_hy = hyena_mixer(p_hy, conv_w[l], conv_b[l], hy_w1[l], hy_b1[l], hy_f1[l],
                           hy_w2[l], hy_b2[l], hy_f2[l], hy_w3[l], hy_d[l])
        q_na, k_na, v_na = jnp.split(p_na, 3, axis=-1)
        y_na = neighbourhood_attention(q_na, k_na, v_na, na_rpb[l])
        y_ml = latent_attention(p_cq, p_ckv, p_kr, q_norm_g[l], w_uq[l], kv_norm_g[l], w_ukv[l])
        g = grp_norm_g[l]
        mix = jnp.concatenate([rms_norm(y_hy, g[:HY_W]),
                               rms_norm(y_na, g[HY_W:HY_W + NA_W]),
                               rms_norm(y_ml, g[HY_W + NA_W:])], -1)
        x = layer_norm(ALPHA * x + mix @ w_out[l], ln1_g[l], ln1_b[l])
        ff = grouped_moe(x.reshape(B * L, D), router_w, router_b,
                         exp_w_gate[l], exp_w_up[l], exp_w_down[l]).reshape(B, L, D)
        x = layer_norm(ALPHA * x + ff, ln2_g[l], ln2_b[l])
    return x
```

```cpp
#include <hip/hip_runtime.h>
#include <cstdio>
#include <cstdint>
#include <utility>
#define LAS __attribute__((address_space(3)))
constexpr int LC_WID = 157696 + 2048;
__device__ __forceinline__ int mk_tid() {
    int lane; asm volatile("v_mbcnt_lo_u32_b32 %0, -1, 0\n\tv_mbcnt_hi_u32_b32 %0, -1, %0" : "=v"(lane));
    const unsigned hw = (unsigned)__builtin_amdgcn_s_getreg((5 << 11) | 4) & 63u;
    const int wv = ((const LAS int*)(unsigned)LC_WID)[hw];
    return wv * 64 + lane;
}
__device__ __forceinline__ float shx(float v, int o, int lane) { return __builtin_bit_cast(float, __builtin_amdgcn_ds_bpermute((lane ^ o) << 2, __builtin_bit_cast(int, v))); }
__device__ __forceinline__ int shup_i(int v, int o, int lane) { return __builtin_amdgcn_ds_bpermute(((lane - o) & 63) << 2, v); }
__device__ __forceinline__ float fadd_s(float a, float b) { float r; asm("v_add_f32_e32 %0, %1, %2" : "=v"(r) : "v"(a), "v"(b)); return r; }
__device__ __forceinline__ float fsub_s(float a, float b) { float r; asm("v_sub_f32_e32 %0, %1, %2" : "=v"(r) : "v"(a), "v"(b)); return r; }
__device__ __forceinline__ float fmul_s(float a, float b) { float r; asm("v_mul_f32_e32 %0, %1, %2" : "=v"(r) : "v"(a), "v"(b)); return r; }
__device__ __forceinline__ float ffma_s(float a, float b, float c) { float r; asm("v_fma_f32 %0, %1, %2, %3" : "=v"(r) : "v"(a), "v"(b), "v"(c)); return r; }
__device__ __forceinline__ float ffnma_s(float a, float b, float c) { float r; asm("v_fma_f32 %0, %1, %2, -%3" : "=v"(r) : "v"(a), "v"(b), "v"(c)); return r; }
namespace pg8 {
#define PG8_LAS __attribute__((address_space(3)))
typedef unsigned short bf16_t;
typedef short bf16x8 __attribute__((ext_vector_type(8)));
typedef float f32x4 __attribute__((ext_vector_type(4)));
typedef unsigned u32x4 __attribute__((ext_vector_type(4)));
constexpr int BM = 256, BK = 64, HALF = 128, HTB = HALF * BK * 2  , STAGE_BYTES = 8 * HTB, NXCD = 8, WGM = 8;

__host__ __device__ __forceinline__ int lds_byte(int r, int c) { const int st = (r >> 4) * 2 + (c >> 5), rr = r & 15, cc = c & 31, ob = rr * 64 + cc * 2; return st * 1024 + (ob ^ (((ob >> 9) & 1) << 5)); }
__host__ __device__ __forceinline__ void stage_rc(int b, int& R, int& C) { const int st = b / 1024, sb = b % 1024, swz = sb ^ (((sb >> 9) & 1) << 5); R = (st >> 1) * 16 + swz / 64; C = (st & 1) * 32 + (swz % 64) / 2; }
__host__ __device__ __forceinline__ int perm32(int rho) { const int n = rho >> 4, i = rho & 15; return 8 * (i >> 2) + 4 * n + (i & 3); }

struct Unit { int pm, pn; };
struct Gemm { const bf16_t* A; const bf16_t* Bt; int M, N, K; };

struct StaticOrder {
    int nM, nN, nwg, G, c;
    __host__ __device__ void init(int M, int N, int G_, int c_) { nM = M / BM; nN = N / BM; nwg = nM * nN; G = G_; c = c_; }
    __host__ __device__ bool next(int i, Unit& u) const {
        const long L = (long)i * G + c; if (L >= nwg) return false;
        int wgid = (int)L; { const int q = nwg / NXCD, r = nwg % NXCD, xcd = wgid % NXCD, off = wgid / NXCD; wgid = (xcd < r ? xcd * (q + 1) : r * (q + 1) + (xcd - r) * q) + off; }
        const int nig = WGM * nN, gid = wgid / nig, fm = gid * WGM, gsz = (nM - fm) < WGM ? (nM - fm) : WGM;
        u.pm = fm + ((wgid % nig) % gsz); u.pn = (wgid % nig) / gsz; return true;
    }
    __device__ __forceinline__ void a_ready(const Unit&) const {}
    __device__ __forceinline__ void done(const Unit&) const {}
};
__device__ __forceinline__ unsigned cvt_pk_bf16(float lo, float hi) { unsigned r; asm volatile("v_cvt_pk_bf16_f32 %0, %1, %2" : "=v"(r) : "v"(lo), "v"(hi)); return r; }
typedef unsigned u32x2 __attribute__((ext_vector_type(2)));
struct MoeOrder {
    const PG8_LAS int* tile_e; int ntiles, NTN, G, c; const u32x2* tabE; const PG8_LAS int* tp; const PG8_LAS int* cnt;
    __device__ __forceinline__ int arow(const Unit& u, int r) const { const int e = tile_e[u.pm], p = 256 * (u.pm - tp[e]) + r; return p < cnt[e] ? (int)(tabE[(size_t)e * 32768 + p].x >> 1) : 0; }
    __device__ __forceinline__ bool next(int i, Unit& u) const {
        int tm, pl;
        if (G == 256) {
            const int xcd = c & 7, slot = c >> 3, rpr = 256 / NTN; tm = i * rpr + xcd * (rpr >> 3) + slot / NTN; pl = slot % NTN; if (tm >= ntiles) return false; }
        else { const long Lx = (long)i * G + c; if (Lx >= (long)ntiles * NTN) return false; tm = (int)(Lx / NTN); pl = (int)(Lx % NTN); }
        u.pm = tm; u.pn = tile_e[tm] * NTN + pl; return true;
    }
    __device__ __forceinline__ void a_ready(const Unit&) const {}
    __device__ __forceinline__ void done(const Unit&) const {}
};
__device__ __forceinline__ u32x4 pack8(const f32x4 v0, const f32x4 v1) { u32x4 w; w.x = cvt_pk_bf16(v0[0], v0[1]); w.y = cvt_pk_bf16(v0[2], v0[3]); w.z = cvt_pk_bf16(v1[0], v1[1]); w.w = cvt_pk_bf16(v1[2], v1[3]); return w; }
typedef float f32x2 __attribute__((ext_vector_type(2)));
__device__ __forceinline__ u32x2 pack4(const f32x4 v) { u32x2 w; w.x = cvt_pk_bf16(v[0], v[1]); w.y = cvt_pk_bf16(v[2], v[3]); return w; }

struct EpiProj {
    static constexpr bool PERM = true, AFTER_DRAIN = false;
    bf16_t *U, *QKV, *CQ, *CKV, *KR;
    __device__ __forceinline__ void operator()(const f32x4 (&acc)[2][2][4][2], const Unit& u, int wr, int wc, int fr, int fq) const {
        const int pn = u.pn; bf16_t* base; int ldc, colt, ncols = 256;
        if (pn < 6) { base = U; ldc = 1536; colt = pn * 256; }
        else if (pn < 12) { base = QKV; ldc = 1536; colt = (pn - 6) * 256; }
        else if (pn < 14) { base = CQ; ldc = 512; colt = (pn - 12) * 256; }
        else if (pn == 14) { base = CKV; ldc = 256; colt = 0; }
        else { base = KR; ldc = 64; colt = 0; ncols = 64; }
        const int row0 = u.pm * BM + wr * 64 + fr, cin = wc * 32 + 8 * fq;
#pragma unroll
        for (int ai = 0; ai < 2; ++ai)
#pragma unroll
            for (int m = 0; m < 4; ++m) { bf16_t* rowp = base + (size_t)(row0 + ai * HALF + m * 16) * ldc + colt + cin;
#pragma unroll
                for (int bj = 0; bj < 2; ++bj) if (bj * HALF + cin < ncols) *(u32x4*)(rowp + bj * HALF) = pack8(acc[ai][bj][m][0], acc[ai][bj][m][1]);
                asm volatile("" ::: "memory"); }
    }
};
struct EpiQ {
    static constexpr bool PERM = false, AFTER_DRAIN = false;
    bf16_t *QN, *QR; const float* rq; const float* cosT; const float* sinT; float qscale; int Lmask;
    __device__ __forceinline__ void operator()(const f32x4 (&acc)[2][2][4][2], const Unit& u, int wr, int wc, int fr, int fq) const {
        const int row0 = u.pm * BM + wr * 64 + fr, pn = u.pn;
        float sc[2][4];
#pragma unroll
        for (int ai = 0; ai < 2; ++ai)
#pragma unroll
            for (int m = 0; m < 4; ++m) sc[ai][m] = rq[row0 + ai * HALF + m * 16];
#pragma unroll
        for (int ai = 0; ai < 2; ++ai)
#pragma unroll
            for (int m = 0; m < 4; ++m) { const int row = row0 + ai * HALF + m * 16; const float s = sc[ai][m] * qscale;
                if (pn < 4) { bf16_t* rowp = QN + (size_t)row * 1024 + pn * 256 + wc * 32 + 4 * fq;
#pragma unroll
                    for (int bj = 0; bj < 2; ++bj)
#pragma unroll
                        for (int n = 0; n < 2; ++n) *(u32x2*)(rowp + bj * HALF + n * 16) = pack4(acc[ai][bj][m][n] * s);
                } else { const int head = (pn - 4) * 4 + wc, pos = row & Lmask; bf16_t* rowp = QR + (size_t)row * 512 + head * 64 + 4 * fq;
#pragma unroll
                    for (int n = 0; n < 2; ++n) { const int d = n * 16 + 4 * fq; const f32x4 c4 = *(const f32x4*)(cosT + pos * 32 + d), s4 = *(const f32x4*)(sinT + pos * 32 + d);
                        const f32x4 x1 = acc[ai][0][m][n] * s, x2 = acc[ai][1][m][n] * s;
                        *(u32x2*)(rowp + n * 16) = pack4(x1 * c4 - x2 * s4); *(u32x2*)(rowp + 32 + n * 16) = pack4(x1 * s4 + x2 * c4); asm volatile("" ::: "memory"); } }
                asm volatile("" ::: "memory");
            }
    }
};
struct EpiKV {
    static constexpr bool PERM = true, AFTER_DRAIN = false;
    bf16_t *KN, *V; const float* rkv;
    __device__ __forceinline__ void operator()(const f32x4 (&acc)[2][2][4][2], const Unit& u, int wr, int wc, int fr, int fq) const {
        const int pn = u.pn; bf16_t* base = pn < 4 ? KN : V; const int colt = (pn & 3) * 256 + wc * 32 + 8 * fq, row0 = u.pm * BM + wr * 64 + fr;
        float sc[2][4];
#pragma unroll
        for (int ai = 0; ai < 2; ++ai)
#pragma unroll
            for (int m = 0; m < 4; ++m) sc[ai][m] = rkv[row0 + ai * HALF + m * 16];
#pragma unroll
        for (int ai = 0; ai < 2; ++ai)
#pragma unroll
            for (int m = 0; m < 4; ++m) { const int row = row0 + ai * HALF + m * 16; const float s = sc[ai][m]; bf16_t* rowp = base + (size_t)row * 1024 + colt;
#pragma unroll
                for (int bj = 0; bj < 2; ++bj) *(u32x4*)(rowp + bj * HALF) = pack8(acc[ai][bj][m][0] * s, acc[ai][bj][m][1] * s);
                asm volatile("" ::: "memory"); }
    }
};
struct EpiOut {
    static constexpr bool PERM = true, AFTER_DRAIN = false;
    const bf16_t* xres; bf16_t* H1; f32x2* part; float alpha;
    __device__ __forceinline__ void operator()(const f32x4 (&acc)[2][2][4][2], const Unit& u, int wr, int wc, int fr, int fq) const {
        const int row0 = u.pm * BM + wr * 64 + fr, col0 = u.pn * BM + wc * 32 + 8 * fq;
#pragma unroll
        for (int ai = 0; ai < 2; ++ai) {
            u32x4 xr[1][4][2];
#pragma unroll
            for (int m = 0; m < 4; ++m)
#pragma unroll
                for (int bj = 0; bj < 2; ++bj) xr[0][m][bj] = *(const u32x4*)(xres + (size_t)(row0 + ai * HALF + m * 16) * 2048 + col0 + bj * HALF);
            asm volatile("" ::: "memory");
#pragma unroll
            for (int m = 0; m < 4; ++m) { const int row = row0 + ai * HALF + m * 16; const size_t off = (size_t)row * 2048 + col0; float s = 0.f, q = 0.f;
#pragma unroll
                for (int bj = 0; bj < 2; ++bj) { const u32x4 xw = xr[0][m][bj];
                    f32x4 h0, h1;
                    h0[0] = __uint_as_float(xw.x << 16) * alpha + acc[ai][bj][m][0][0]; h0[1] = __uint_as_float(xw.x & 0xffff0000u) * alpha + acc[ai][bj][m][0][1];
                    h0[2] = __uint_as_float(xw.y << 16) * alpha + acc[ai][bj][m][0][2]; h0[3] = __uint_as_float(xw.y & 0xffff0000u) * alpha + acc[ai][bj][m][0][3];
                    h1[0] = __uint_as_float(xw.z << 16) * alpha + acc[ai][bj][m][1][0]; h1[1] = __uint_as_float(xw.z & 0xffff0000u) * alpha + acc[ai][bj][m][1][1];
                    h1[2] = __uint_as_float(xw.w << 16) * alpha + acc[ai][bj][m][1][2]; h1[3] = __uint_as_float(xw.w & 0xffff0000u) * alpha + acc[ai][bj][m][1][3];
                    *(u32x4*)(H1 + off + bj * HALF) = pack8(h0, h1);
                    s += ((h0[0] + h0[1]) + (h0[2] + h0[3])) + ((h1[0] + h1[1]) + (h1[2] + h1[3]));
                    q += ((h0[0] * h0[0] + h0[1] * h0[1]) + (h0[2] * h0[2] + h0[3] * h0[3])) + ((h1[0] * h1[0] + h1[1] * h1[1]) + (h1[2] * h1[2] + h1[3] * h1[3])); }
                { const int ln = fq * 16 + fr; s += shx(s, 16, ln); s += shx(s, 32, ln); q += shx(q, 16, ln); q += shx(q, 32, ln); }
                if (fq == 0) part[(size_t)row * 32 + u.pn * 4 + wc] = (f32x2){s, q};
                asm volatile("" ::: "memory"); }
        }
    }
};
struct EpiGU {
    static constexpr bool PERM = true, AFTER_DRAIN = false;
    bf16_t* HH;
    __device__ __forceinline__ void operator()(const f32x4 (&acc)[2][2][4][2], const Unit& u, int wr, int wc, int fr, int fq) const {
        const int row0 = u.pm * BM + wr * 64 + fr, colt = (u.pn & 3) * 128 + wc * 32 + 8 * fq;
#pragma unroll
        for (int ai = 0; ai < 2; ++ai)
#pragma unroll
            for (int m = 0; m < 4; ++m) { bf16_t* rowp = HH + (size_t)(row0 + ai * HALF + m * 16) * 512 + colt; f32x4 h[2];
#pragma unroll
                for (int n = 0; n < 2; ++n) { const f32x4 g = acc[ai][0][m][n], up = acc[ai][1][m][n];
#pragma unroll
                    for (int j = 0; j < 4; ++j) h[n][j] = g[j] * __builtin_amdgcn_rcpf(1.0f + __expf(-g[j])) * up[j]; }
                *(u32x4*)rowp = pack8(h[0], h[1]); asm volatile("" ::: "memory"); }
    }
};
struct EpiDown {
    static constexpr bool PERM = true, AFTER_DRAIN = false;
    bf16_t* FF; const u32x2* tabE; const PG8_LAS int* tp; const PG8_LAS int* cnt;
    __device__ __forceinline__ void operator()(const f32x4 (&acc)[2][2][4][2], const Unit& u, int wr, int wc, int fr, int fq) const {
        const int e = u.pn >> 3, colt = (u.pn & 7) * 256 + wc * 32 + 8 * fq, p0 = 256 * (u.pm - tp[e]), lim = cnt[e] - p0; const u32x2* tb = tabE + (size_t)e * 32768 + p0;
        u32x2 te[2][4];
#pragma unroll
        for (int ai = 0; ai < 2; ++ai)
#pragma unroll
            for (int m = 0; m < 4; ++m) { const int lr = wr * 64 + fr + ai * HALF + m * 16; te[ai][m] = (u32x2){0u, 0u}; if (lr < lim) te[ai][m] = tb[lr]; }
#pragma unroll
        for (int ai = 0; ai < 2; ++ai)
#pragma unroll
            for (int m = 0; m < 4; ++m) { const int lr = wr * 64 + fr + ai * HALF + m * 16;
                if (lr < lim) { const u32x2 t2 = te[ai][m]; const int ri = (int)t2.x; const float w = __uint_as_float(t2.y); bf16_t* rowp = FF + (size_t)ri * 2048 + colt;
#pragma unroll
                    for (int bj = 0; bj < 2; ++bj) *(u32x4*)(rowp + bj * HALF) = pack8(acc[ai][bj][m][0] * w, acc[ai][bj][m][1] * w); }
                asm volatile("" ::: "memory"); }
    }
};
template <class Epi, class Sched, bool ALIGN_EPI = false, bool SP2 = false>
__device__ __forceinline__ void gemm_phase(PG8_LAS unsigned char* lds, const Gemm g, const Sched& S, const Epi& E) {
    int tid_ = mk_tid(); asm volatile("" : "+v"(tid_));
    const int tid = tid_, wid = __builtin_amdgcn_readfirstlane(tid >> 6), lane = tid & 63, wr = wid >> 2, wc = wid & 3, fr = lane & 15, fq = lane >> 4;
    const int K = g.K, nt = K / BK;
    unsigned voffA[2], voffB[2];
#pragma unroll
    for (int i = 0; i < 2; ++i) { int R, C; stage_rc(tid * 16 + i * 8192, R, C); const int Rb = Epi::PERM ? ((R & ~31) + perm32(R & 31)) : R;
        voffA[i] = (unsigned)(R * K + C) * 2u; voffB[i] = (unsigned)(Rb * K + C) * 2u; }
    const size_t kstep = (size_t)(BK * 2);
    const size_t hstep = (size_t)HALF * K * 2;
    const size_t tstep = 2 * hstep;
    const unsigned ldsw = (unsigned)wid * 1024u;
    const int aoff = lds_byte(wr * 64 + fr, fq * 8), boff = lds_byte(wc * 32 + fr, fq * 8);
#define PG8_SA(b, h) (((b) * 2 + (h)) * HTB)
#define PG8_SB(b, h) ((4 + (b) * 2 + (h)) * HTB)
#define PG8_STAGE(bufoff, gbase, voff) do { _Pragma("unroll") for (int _i = 0; _i < 2; ++_i) \
        __builtin_amdgcn_global_load_lds((const unsigned*)((const char*)(gbase) + (voff)[_i]), (PG8_LAS unsigned*)(lds + (bufoff) + ldsw + _i * 8192), 16, 0, 0); } while (0)
#define PG8_LDA(dst, b, h) do { _Pragma("unroll") for (int m = 0; m < 4; ++m) _Pragma("unroll") for (int k = 0; k < 2; ++k) dst[m][k] = *(const PG8_LAS bf16x8*)(lds + PG8_SA(b, h) + aoff + m * 2048 + k * 1024); } while (0)
#define PG8_LDB(dst, b, h) do { _Pragma("unroll") for (int n = 0; n < 2; ++n) _Pragma("unroll") for (int k = 0; k < 2; ++k) dst[n][k] = *(const PG8_LAS bf16x8*)(lds + PG8_SB(b, h) + boff + n * 2048 + k * 1024); } while (0)
#define PG8_MMA(ai, bj, At, Bt) do { __builtin_amdgcn_s_setprio(1); _Pragma("unroll") for (int m = 0; m < 4; ++m) _Pragma("unroll") for (int n = 0; n < 2; ++n) _Pragma("unroll") for (int k = 0; k < 2; ++k) \
        acc[ai][bj][m][n] = __builtin_amdgcn_mfma_f32_16x16x32_bf16(Bt[n][k], At[m][k], acc[ai][bj][m][n], 0, 0, 0); __builtin_amdgcn_s_setprio(0); } while (0)
#define PG8_WAIT_V(n) asm volatile("s_waitcnt vmcnt(" #n ")" ::: "memory")
#define PG8_WAIT_L(n) asm volatile("s_waitcnt lgkmcnt(" #n ")" ::: "memory")
#define PG8_BAR __builtin_amdgcn_s_barrier()
#define PG8_SCHED __builtin_amdgcn_sched_barrier(0)
    Unit cur, nxt; int ui = 0;
    float zf_ = 0.f; asm volatile("" : "+v"(zf_));
    if (!S.next(0, cur)) return;
    f32x4 acc[2][2][4][2];
#pragma unroll
    for (int a = 0; a < 2; ++a)
#pragma unroll
        for (int b = 0; b < 2; ++b)
#pragma unroll
            for (int m = 0; m < 4; ++m)
#pragma unroll
                for (int n = 0; n < 2; ++n) acc[a][b][m][n] = (f32x4){zf_, zf_, zf_, zf_};
    bf16x8 At[4][2], B0[2][2], B1[2][2];
    const char* cA = (const char*)g.A + (size_t)cur.pm * tstep; const char* cB = (const char*)g.Bt + (size_t)cur.pn * tstep;
    S.a_ready(cur);
    if constexpr (SP2) {
        PG8_STAGE(PG8_SB(0, 0), cB, voffB); PG8_STAGE(PG8_SB(0, 1), cB + hstep, voffB); PG8_STAGE(PG8_SA(0, 0), cA, voffA); PG8_STAGE(PG8_SA(0, 1), cA + hstep, voffA);
        if (wr == 1) PG8_BAR;
        PG8_WAIT_V(2); PG8_BAR;
        PG8_STAGE(PG8_SB(1, 0), cB + kstep, voffB); PG8_STAGE(PG8_SA(1, 0), cA + kstep, voffA); PG8_STAGE(PG8_SB(1, 1), cB + hstep + kstep, voffB);
        PG8_WAIT_V(6); PG8_BAR;
    } else {
        PG8_STAGE(PG8_SB(0, 0), cB, voffB); PG8_STAGE(PG8_SA(0, 0), cA, voffA); PG8_STAGE(PG8_SB(0, 1), cB + hstep, voffB); PG8_STAGE(PG8_SA(0, 1), cA + hstep, voffA);
        if (wr == 1) PG8_BAR;
        PG8_WAIT_V(4); PG8_BAR;
        PG8_STAGE(PG8_SB(1, 0), cB + kstep, voffB); PG8_STAGE(PG8_SA(1, 0), cA + kstep, voffA); PG8_STAGE(PG8_SB(1, 1), cB + hstep + kstep, voffB);
        PG8_WAIT_V(6); PG8_BAR;
    }
    for (;;) {
        const bool has_next = S.next(ui + 1, nxt);
        const char* nA = has_next ? (const char*)g.A + (size_t)nxt.pm * tstep : cA; const char* nB = has_next ? (const char*)g.Bt + (size_t)nxt.pn * tstep : cB;
#pragma unroll 1
        for (int t = 0; t < nt; t += 2) {
            const bool last = (t == nt - 2);
            const char* a1 = cA + (size_t)(t + 1) * kstep;
            const char* a2 = last ? nA : cA + (size_t)(t + 2) * kstep; const char* b2 = last ? nB : cB + (size_t)(t + 2) * kstep;
            const char* a3 = a2 + kstep; const char* b3 = b2 + kstep;
            if (last && has_next) S.a_ready(nxt);
            if constexpr (SP2) {
            PG8_LDB(B0, 0, 0); PG8_LDB(B1, 0, 1); PG8_SCHED; PG8_LDA(At, 0, 0); PG8_STAGE(PG8_SA(1, 1), a1 + hstep, voffA);
            PG8_WAIT_V(8); PG8_WAIT_L(0); PG8_BAR; PG8_MMA(0, 0, At, B0); PG8_MMA(0, 1, At, B1); PG8_BAR; PG8_SCHED;
            PG8_LDA(At, 0, 1); PG8_STAGE(PG8_SB(0, 0), b2, voffB); PG8_STAGE(PG8_SB(0, 1), b2 + hstep, voffB); PG8_STAGE(PG8_SA(0, 0), a2, voffA);
            PG8_WAIT_V(8); PG8_WAIT_L(0); PG8_BAR; PG8_MMA(1, 0, At, B0); PG8_MMA(1, 1, At, B1); PG8_BAR; PG8_SCHED;
            PG8_LDB(B0, 1, 0); PG8_LDB(B1, 1, 1); PG8_SCHED; PG8_LDA(At, 1, 0); PG8_STAGE(PG8_SA(0, 1), a2 + hstep, voffA);
            PG8_WAIT_V(8); PG8_WAIT_L(0); PG8_BAR; PG8_MMA(0, 0, At, B0); PG8_MMA(0, 1, At, B1); PG8_BAR; PG8_SCHED;
            PG8_LDA(At, 1, 1); PG8_STAGE(PG8_SB(1, 0), b3, voffB); PG8_STAGE(PG8_SB(1, 1), b3 + hstep, voffB); PG8_STAGE(PG8_SA(1, 0), a3, voffA);
            PG8_WAIT_V(8); PG8_WAIT_L(0); PG8_BAR; PG8_MMA(1, 0, At, B0); PG8_MMA(1, 1, At, B1); PG8_BAR; PG8_SCHED;
            } else {
            PG8_LDB(B0, 0, 0); PG8_SCHED; PG8_LDA(At, 0, 0); PG8_STAGE(PG8_SA(1, 1), a1 + hstep, voffA);
            PG8_WAIT_L(8); PG8_BAR; PG8_WAIT_L(0); PG8_MMA(0, 0, At, B0); PG8_BAR; PG8_SCHED;
            PG8_LDB(B1, 0, 1); PG8_STAGE(PG8_SB(0, 0), b2, voffB);
            PG8_BAR; PG8_WAIT_L(0); PG8_MMA(0, 1, At, B1); PG8_BAR;
            PG8_LDA(At, 0, 1); PG8_STAGE(PG8_SA(0, 0), a2, voffA);
            PG8_BAR; PG8_WAIT_L(0); PG8_MMA(1, 0, At, B0); PG8_BAR; PG8_SCHED;
            PG8_STAGE(PG8_SB(0, 1), b2 + hstep, voffB);
            PG8_WAIT_V(6); PG8_BAR; PG8_MMA(1, 1, At, B1); PG8_BAR;
            PG8_LDB(B0, 1, 0); PG8_SCHED; PG8_LDA(At, 1, 0); PG8_STAGE(PG8_SA(0, 1), a2 + hstep, voffA);
            PG8_WAIT_L(8); PG8_BAR; PG8_WAIT_L(0); PG8_MMA(0, 0, At, B0); PG8_BAR; PG8_SCHED;
            PG8_LDB(B1, 1, 1); PG8_STAGE(PG8_SB(1, 0), b3, voffB);
            PG8_BAR; PG8_WAIT_L(0); PG8_MMA(0, 1, At, B1); PG8_BAR;
            PG8_LDA(At, 1, 1); PG8_STAGE(PG8_SA(1, 0), a3, voffA);
            PG8_BAR; PG8_WAIT_L(0); PG8_MMA(1, 0, At, B0); PG8_BAR; PG8_SCHED;
            PG8_STAGE(PG8_SB(1, 1), b3 + hstep, voffB);
            PG8_WAIT_V(6); PG8_BAR; PG8_MMA(1, 1, At, B1); PG8_BAR;
            }
        }
        if constexpr (ALIGN_EPI) { if (wr == 0) PG8_BAR; }
        if constexpr (!Epi::AFTER_DRAIN) { E(acc, cur, wr, wc, fr, fq); S.done(cur); }
        if (!has_next) break;
#pragma unroll
        for (int a = 0; a < 2; ++a)
#pragma unroll
            for (int b = 0; b < 2; ++b)
#pragma unroll
                for (int m = 0; m < 4; ++m)
#pragma unroll
                    for (int n = 0; n < 2; ++n) acc[a][b][m][n] = (f32x4){zf_, zf_, zf_, zf_};
        cur = nxt; cA = nA; cB = nB; ++ui;
        if constexpr (ALIGN_EPI) { if (wr == 1) PG8_BAR; }
    }
    PG8_WAIT_V(0);
    if constexpr (!ALIGN_EPI) { if (wr == 0) PG8_BAR; }
    PG8_BAR;
    if constexpr (Epi::AFTER_DRAIN) { E.fused(acc, cur, wr, wc, fr, fq, lds, wid, lane); S.done(cur); }
#undef PG8_SA
#undef PG8_SB
#undef PG8_STAGE
#undef PG8_LDA
#undef PG8_LDB
#undef PG8_MMA
#undef PG8_WAIT_V
#undef PG8_WAIT_L
#undef PG8_BAR
#undef PG8_SCHED
}
template <class Epi, class Sched, bool ALIGN_EPI = false, bool SP2 = false>
__device__ __forceinline__ void gemm_phase_g(PG8_LAS unsigned char* lds, const Gemm g, const Sched& S, const Epi& E) {
    int tid_ = mk_tid(); asm volatile("" : "+v"(tid_));
    const int tid = tid_, wid = __builtin_amdgcn_readfirstlane(tid >> 6), lane = tid & 63, wr = wid >> 2, wc = wid & 3, fr = lane & 15, fq = lane >> 4;
    const int K = g.K, nt = K / BK;
    unsigned voffB[2]; int RA[2], CA[2];
#pragma unroll
    for (int i = 0; i < 2; ++i) { int R, C; stage_rc(tid * 16 + i * 8192, R, C); const int Rb = Epi::PERM ? ((R & ~31) + perm32(R & 31)) : R;
        RA[i] = R; CA[i] = C; voffB[i] = (unsigned)(Rb * K + C) * 2u; }
    unsigned va0[2], va1[2], vn0[2], vn1[2];
#define PG8_AOFF(u, d0, d1) do { _Pragma("unroll") for (int _i = 0; _i < 2; ++_i) { d0[_i] = (unsigned)(S.arow(u, RA[_i]) * K + CA[_i]) * 2u; d1[_i] = (unsigned)(S.arow(u, HALF + RA[_i]) * K + CA[_i]) * 2u; } } while (0)
    const size_t kstep = (size_t)(BK * 2);
    const size_t hstep = (size_t)HALF * K * 2;
    const size_t tstep = 2 * hstep;
    const unsigned ldsw = (unsigned)wid * 1024u;
    const int aoff = lds_byte(wr * 64 + fr, fq * 8), boff = lds_byte(wc * 32 + fr, fq * 8);
#define PG8_SA(b, h) (((b) * 2 + (h)) * HTB)
#define PG8_SB(b, h) ((4 + (b) * 2 + (h)) * HTB)
#define PG8_STAGE(bufoff, gbase, voff) do { _Pragma("unroll") for (int _i = 0; _i < 2; ++_i) \
        __builtin_amdgcn_global_load_lds((const unsigned*)((const char*)(gbase) + (voff)[_i]), (PG8_LAS unsigned*)(lds + (bufoff) + ldsw + _i * 8192), 16, 0, 0); } while (0)
#define PG8_LDA(dst, b, h) do { _Pragma("unroll") for (int m = 0; m < 4; ++m) _Pragma("unroll") for (int k = 0; k < 2; ++k) dst[m][k] = *(const PG8_LAS bf16x8*)(lds + PG8_SA(b, h) + aoff + m * 2048 + k * 1024); } while (0)
#define PG8_LDB(dst, b, h) do { _Pragma("unroll") for (int n = 0; n < 2; ++n) _Pragma("unroll") for (int k = 0; k < 2; ++k) dst[n][k] = *(const PG8_LAS bf16x8*)(lds + PG8_SB(b, h) + boff + n * 2048 + k * 1024); } while (0)
#define PG8_MMA(ai, bj, At, Bt) do { __builtin_amdgcn_s_setprio(1); _Pragma("unroll") for (int m = 0; m < 4; ++m) _Pragma("unroll") for (int n = 0; n < 2; ++n) _Pragma("unroll") for (int k = 0; k < 2; ++k) \
        acc[ai][bj][m][n] = __builtin_amdgcn_mfma_f32_16x16x32_bf16(Bt[n][k], At[m][k], acc[ai][bj][m][n], 0, 0, 0); __builtin_amdgcn_s_setprio(0); } while (0)
#define PG8_WAIT_V(n) asm volatile("s_waitcnt vmcnt(" #n ")" ::: "memory")
#define PG8_WAIT_L(n) asm volatile("s_waitcnt lgkmcnt(" #n ")" ::: "memory")
#define PG8_BAR __builtin_amdgcn_s_barrier()
#define PG8_SCHED __builtin_amdgcn_sched_barrier(0)
    Unit cur, nxt; int ui = 0;
    float zf_ = 0.f; asm volatile("" : "+v"(zf_));
    if (!S.next(0, cur)) return;
    f32x4 acc[2][2][4][2];
#pragma unroll
    for (int a = 0; a < 2; ++a)
#pragma unroll
        for (int b = 0; b < 2; ++b)
#pragma unroll
            for (int m = 0; m < 4; ++m)
#pragma unroll
                for (int n = 0; n < 2; ++n) acc[a][b][m][n] = (f32x4){zf_, zf_, zf_, zf_};
    bf16x8 At[4][2], B0[2][2], B1[2][2];
    const char* cA = (const char*)g.A; const char* cB = (const char*)g.Bt + (size_t)cur.pn * tstep;
    S.a_ready(cur);
    PG8_AOFF(cur, va0, va1);
    if constexpr (SP2) {
        PG8_STAGE(PG8_SB(0, 0), cB, voffB); PG8_STAGE(PG8_SB(0, 1), cB + hstep, voffB); PG8_STAGE(PG8_SA(0, 0), cA, va0); PG8_STAGE(PG8_SA(0, 1), cA, va1);
        if (wr == 1) PG8_BAR;
        PG8_WAIT_V(2); PG8_BAR;
        PG8_STAGE(PG8_SB(1, 0), cB + kstep, voffB); PG8_STAGE(PG8_SA(1, 0), cA + kstep, va0); PG8_STAGE(PG8_SB(1, 1), cB + hstep + kstep, voffB);
        PG8_WAIT_V(6); PG8_BAR;
    } else {
        PG8_STAGE(PG8_SB(0, 0), cB, voffB); PG8_STAGE(PG8_SA(0, 0), cA, va0); PG8_STAGE(PG8_SB(0, 1), cB + hstep, voffB); PG8_STAGE(PG8_SA(0, 1), cA, va1);
        if (wr == 1) PG8_BAR;
        PG8_WAIT_V(4); PG8_BAR;
        PG8_STAGE(PG8_SB(1, 0), cB + kstep, voffB); PG8_STAGE(PG8_SA(1, 0), cA + kstep, va0); PG8_STAGE(PG8_SB(1, 1), cB + hstep + kstep, voffB);
        PG8_WAIT_V(6); PG8_BAR;
    }
    for (;;) {
        const bool has_next = S.next(ui + 1, nxt);
        if (has_next) PG8_AOFF(nxt, vn0, vn1); else { vn0[0] = va0[0]; vn0[1] = va0[1]; vn1[0] = va1[0]; vn1[1] = va1[1]; }
        const char* nA = cA; const char* nB = has_next ? (const char*)g.Bt + (size_t)nxt.pn * tstep : cB;
#pragma unroll 1
        for (int t = 0; t < nt; t += 2) {
            const bool last = (t == nt - 2);
            const char* a1 = cA + (size_t)(t + 1) * kstep;
            const char* a2 = last ? nA : cA + (size_t)(t + 2) * kstep; const char* b2 = last ? nB : cB + (size_t)(t + 2) * kstep;
            const char* a3 = a2 + kstep; const char* b3 = b2 + kstep;
            unsigned w0[2], w1[2]; w0[0] = last ? vn0[0] : va0[0]; w0[1] = last ? vn0[1] : va0[1]; w1[0] = last ? vn1[0] : va1[0]; w1[1] = last ? vn1[1] : va1[1];
            if (last && has_next) S.a_ready(nxt);
            if constexpr (SP2) {
            PG8_LDB(B0, 0, 0); PG8_LDB(B1, 0, 1); PG8_SCHED; PG8_LDA(At, 0, 0); PG8_STAGE(PG8_SA(1, 1), a1, va1);
            PG8_WAIT_V(8); PG8_WAIT_L(0); PG8_BAR; PG8_MMA(0, 0, At, B0); PG8_MMA(0, 1, At, B1); PG8_BAR; PG8_SCHED;
            PG8_LDA(At, 0, 1); PG8_STAGE(PG8_SB(0, 0), b2, voffB); PG8_STAGE(PG8_SB(0, 1), b2 + hstep, voffB); PG8_STAGE(PG8_SA(0, 0), a2, w0);
            PG8_WAIT_V(8); PG8_WAIT_L(0); PG8_BAR; PG8_MMA(1, 0, At, B0); PG8_MMA(1, 1, At, B1); PG8_BAR; PG8_SCHED;
            PG8_LDB(B0, 1, 0); PG8_LDB(B1, 1, 1); PG8_SCHED; PG8_LDA(At, 1, 0); PG8_STAGE(PG8_SA(0, 1), a2, w1);
            PG8_WAIT_V(8); PG8_WAIT_L(0); PG8_BAR; PG8_MMA(0, 0, At, B0); PG8_MMA(0, 1, At, B1); PG8_BAR; PG8_SCHED;
            PG8_LDA(At, 1, 1); PG8_STAGE(PG8_SB(1, 0), b3, voffB); PG8_STAGE(PG8_SB(1, 1), b3 + hstep, voffB); PG8_STAGE(PG8_SA(1, 0), a3, w0);
            PG8_WAIT_V(8); PG8_WAIT_L(0); PG8_BAR; PG8_MMA(1, 0, At, B0); PG8_MMA(1, 1, At, B1); PG8_BAR; PG8_SCHED;
            } else {
            PG8_LDB(B0, 0, 0); PG8_SCHED; PG8_LDA(At, 0, 0); PG8_STAGE(PG8_SA(1, 1), a1, va1);
            PG8_WAIT_L(8); PG8_BAR; PG8_WAIT_L(0); PG8_MMA(0, 0, At, B0); PG8_BAR; PG8_SCHED;
            PG8_LDB(B1, 0, 1); PG8_STAGE(PG8_SB(0, 0), b2, voffB);
            PG8_BAR; PG8_WAIT_L(0); PG8_MMA(0, 1, At, B1); PG8_BAR;
            PG8_LDA(At, 0, 1); PG8_STAGE(PG8_SA(0, 0), a2, w0);
            PG8_BAR; PG8_WAIT_L(0); PG8_MMA(1, 0, At, B0); PG8_BAR; PG8_SCHED;
            PG8_STAGE(PG8_SB(0, 1), b2 + hstep, voffB);
            PG8_WAIT_V(6); PG8_BAR; PG8_MMA(1, 1, At, B1); PG8_BAR;
            PG8_LDB(B0, 1, 0); PG8_SCHED; PG8_LDA(At, 1, 0); PG8_STAGE(PG8_SA(0, 1), a2, w1);
            PG8_WAIT_L(8); PG8_BAR; PG8_WAIT_L(0); PG8_MMA(0, 0, At, B0); PG8_BAR; PG8_SCHED;
            PG8_LDB(B1, 1, 1); PG8_STAGE(PG8_SB(1, 0), b3, voffB);
            PG8_BAR; PG8_WAIT_L(0); PG8_MMA(0, 1, At, B1); PG8_BAR;
            PG8_LDA(At, 1, 1); PG8_STAGE(PG8_SA(1, 0), a3, w0);
            PG8_BAR; PG8_WAIT_L(0); PG8_MMA(1, 0, At, B0); PG8_BAR; PG8_SCHED;
            PG8_STAGE(PG8_SB(1, 1), b3 + hstep, voffB);
            PG8_WAIT_V(6); PG8_BAR; PG8_MMA(1, 1, At, B1); PG8_BAR;
            }
        }
        if constexpr (ALIGN_EPI) { if (wr == 0) PG8_BAR; }
        if constexpr (!Epi::AFTER_DRAIN) { E(acc, cur, wr, wc, fr, fq); S.done(cur); }
        if (!has_next) break;
#pragma unroll
        for (int a = 0; a < 2; ++a)
#pragma unroll
            for (int b = 0; b < 2; ++b)
#pragma unroll
                for (int m = 0; m < 4; ++m)
#pragma unroll
                    for (int n = 0; n < 2; ++n) acc[a][b][m][n] = (f32x4){zf_, zf_, zf_, zf_};
        cur = nxt; cA = nA; cB = nB; ++ui; va0[0] = vn0[0]; va0[1] = vn0[1]; va1[0] = vn1[0]; va1[1] = vn1[1];
        if constexpr (ALIGN_EPI) { if (wr == 1) PG8_BAR; }
    }
    PG8_WAIT_V(0);
    if constexpr (!ALIGN_EPI) { if (wr == 0) PG8_BAR; }
    PG8_BAR;
    if constexpr (Epi::AFTER_DRAIN) { E.fused(acc, cur, wr, wc, fr, fq, lds, wid, lane); S.done(cur); }
#undef PG8_AOFF
#undef PG8_SA
#undef PG8_SB
#undef PG8_STAGE
#undef PG8_LDA
#undef PG8_LDB
#undef PG8_MMA
#undef PG8_WAIT_V
#undef PG8_WAIT_L
#undef PG8_BAR
#undef PG8_SCHED
}
}
constexpr int NWAVES = 8, NTHR = 512;
constexpr int T = 32768, SEQ = 16384, DM = 2048, INW = 3904, NLAYER = 2, NEXP = 64;
constexpr float LN_EPS = 1e-5f, ALPHA = 1.41421356237f;
constexpr float QSCALE = 0.07216878364870322f * 1.4426950408889634f;
constexpr size_t MiB = 1u << 20;
constexpr size_t WS_CTL = 0, CTL_ZERO_BYTES = 1 * MiB;
constexpr int CW_TMO = 0, CW_BAR = 4096, CW_CNT = 8192, CNT_STRIDE = 32;
constexpr size_t WS_TW = 1 * MiB;
constexpr size_t WS_TWP = 1 * MiB + 256 * 1024;
constexpr size_t WS_ROPE = 2 * MiB;
constexpr size_t WS_WR = 6 * MiB;
constexpr size_t WS_RQ = 7 * MiB, WS_RKV = 7 * MiB + 512 * 1024;
constexpr size_t WS_ROUTE = 8 * MiB;
constexpr size_t WS_GATES = 9 * MiB;
constexpr size_t WS_ROWINFO = 10 * MiB, WS_SLOTW = 11 * MiB;
constexpr size_t WS_PART = 1600 * MiB;
constexpr size_t WS_XB = 16 * MiB;
constexpr size_t WS_R1 = 144 * MiB;
constexpr size_t WS_U = WS_R1, WS_QKV = WS_R1 + 96 * MiB, WS_CQ = WS_R1 + 192 * MiB, WS_CKV = WS_R1 + 224 * MiB, WS_KR = WS_R1 + 240 * MiB;
constexpr size_t WS_H1 = WS_R1;
constexpr size_t WS_R2 = 400 * MiB;
constexpr size_t WS_UT = WS_R2, WS_QN = WS_R2 + 96 * MiB, WS_QR = WS_R2 + 160 * MiB, WS_KN = WS_R2 + 192 * MiB, WS_V = WS_R2 + 256 * MiB, WS_KROT = WS_R2 + 320 * MiB;
constexpr size_t WS_XM = WS_R2;
constexpr size_t WS_TOK = 12 * MiB;
constexpr size_t WS_R3 = 724 * MiB;
constexpr size_t WS_Y = WS_R3, WS_YT = WS_R3 + 96 * MiB, WS_MIX = WS_R3 + 128 * MiB, WS_FF = WS_R3, WS_KT = WS_R3;
constexpr size_t WS_HH = 980 * MiB;
constexpr size_t WS_WIN = 1060 * MiB, WS_WUQ = 1076 * MiB, WS_WUKV = 1078 * MiB, WS_WOUT = 1080 * MiB, WS_WGU = 1088 * MiB, WS_WDN = 1344 * MiB;
constexpr size_t WS_KF = 1472 * MiB;
constexpr size_t WS_TABE = 1608 * MiB;
constexpr size_t WS_END = 1640 * MiB;
constexpr int LDS_MAIN = 157696;
constexpr int LC_BAR = LDS_MAIN;
constexpr int LC_TP = LDS_MAIN + 64, LC_CNT = LC_TP + 65 * 4 + 60, LC_TILEE = LC_CNT + 64 * 4;
constexpr int LC_TWS = 139264;
static_assert(LC_WID == LDS_MAIN + 2048, "LC_WID");
constexpr int LDS_BYTES = LDS_MAIN + 4096;
static_assert(LDS_BYTES <= 163840, "LDS");
static_assert(LC_TILEE + 320 * 4 <= LDS_BYTES, "LDS map");

#define GAS __attribute__((address_space(1)))
typedef unsigned short bf16;
typedef float f32x4 __attribute__((ext_vector_type(4)));
typedef float f32x2 __attribute__((ext_vector_type(2)));
typedef unsigned u32x4 __attribute__((ext_vector_type(4)));
typedef unsigned u32x2 __attribute__((ext_vector_type(2)));
typedef int i32x4 __attribute__((ext_vector_type(4)));
#define LDS_WAIT() asm volatile("s_waitcnt lgkmcnt(0)" ::: "memory")
#define VM_WAIT() asm volatile("s_waitcnt vmcnt(0)" ::: "memory")
__device__ __forceinline__ unsigned pk2(float lo, float hi) { return pg8::cvt_pk_bf16(lo, hi); }
__device__ __forceinline__ float bflo(unsigned w) { return __uint_as_float(w << 16); }
__device__ __forceinline__ float bfhi(unsigned w) { return __uint_as_float(w & 0xffff0000u); }
__device__ __forceinline__ float wave_sum(float v, int lane) {
#pragma unroll
    for (int o = 1; o < 64; o <<= 1) v += shx(v, o, lane);
    return v;
}
__device__ __forceinline__ void row_stats(const f32x2* part, int row, int lane, float& mean, float& rstd) {
    f32x2 p = {0.f, 0.f}; if (lane < 32) p = part[(size_t)row * 32 + lane];
    const float s = wave_sum(p.x, lane), q = wave_sum(p.y, lane); mean = s * (1.0f / 2048.0f); const float var = q * (1.0f / 2048.0f) - mean * mean; rstd = 1.0f / sqrtf(var + 1e-5f);
}
struct Args { const float* in[28]; float* out; unsigned char* ws; int ph_lo, ph_hi; };
struct Frame { LAS unsigned char* lds; int tid, lane, wave, G, bid, gw, NGW; };
enum { I_X = 0, I_WIN, I_CONVW, I_CONVB, I_HW1, I_HB1, I_HF1, I_HW2, I_HB2, I_HF2, I_HW3, I_HD, I_RPB, I_QG, I_WUQ, I_KVG, I_WUKV, I_GRPG, I_WOUT, I_LN1G, I_LN1B, I_RW, I_RB, I_EG, I_EU, I_ED, I_LN2G, I_LN2B };
#define XB_TMO      128
#define XB_XCNT(j)  (256  + 64 * (j))
#define XB_XSUB(j)  (1280 + 64 * (j))
#define XB_XGEN(j)  (2304 + 64 * (j))
#define XB_TOP      3328
#define XB_TOPGEN   3392
#define XCD_BAR_WORDS 3456
#define XB_SPIN_CAP (1u << 18)

__device__ __forceinline__ unsigned xb_ld(unsigned* p)              { return __hip_atomic_load(p, __ATOMIC_RELAXED, __HIP_MEMORY_SCOPE_AGENT); }
__device__ __forceinline__ unsigned xb_add(unsigned* p, unsigned v) { return __hip_atomic_fetch_add(p, v, __ATOMIC_RELAXED, __HIP_MEMORY_SCOPE_AGENT); }
__device__ __forceinline__ unsigned xb_xcc_id() { return (unsigned)__builtin_amdgcn_s_getreg((3 << 11) | 20) & 0xFu; }
#define XB_SPIN(cond, bar) do { unsigned _sp = 0; while (cond) { __builtin_amdgcn_s_sleep(1); \
    if ((++_sp & 255u) == 0u) { if (xb_ld(&(bar)[XB_TMO])) break; if (_sp > XB_SPIN_CAP) { atomicAdd(&(bar)[XB_TMO], 1u); break; } } } } while (0)

struct XcdBarrier {
    unsigned* bar; unsigned x;
    volatile LAS unsigned* st;
};

__device__ __forceinline__ XcdBarrier xcd_barrier_post(unsigned* bar, volatile LAS unsigned* st) {
    XcdBarrier b; b.bar = bar; b.x = xb_xcc_id(); b.st = st;
    if (mk_tid() == 0) (void)xb_add(&bar[XB_XCNT(b.x)], 1u);
    return b;
}
__device__ __forceinline__ void xcd_barrier_complete(unsigned* bar, unsigned x, unsigned& nloc, unsigned& nx) {
    const unsigned G = gridDim.x * gridDim.y * gridDim.z;
    unsigned sum, cnt, mine, sp = 0u;
    for (;;) {
        sum = 0u; cnt = 0u; mine = 0u;
#pragma unroll
        for (unsigned j = 0; j < 16; ++j) { const unsigned c = xb_ld(&bar[XB_XCNT(j)]); sum += c; cnt += (c > 0u) ? 1u : 0u; mine = (j == x) ? c : mine; }
        if (sum == G) break;
        __builtin_amdgcn_s_sleep(1);
        if ((++sp & 255u) == 0u) { if (xb_ld(&bar[XB_TMO])) break; if (sp > XB_SPIN_CAP) { atomicAdd(&bar[XB_TMO], 1u); break; } }
    }
    nloc = mine > 0u ? mine : 1u; nx = cnt > 0u ? cnt : 1u;
}

__device__ __forceinline__ void xcd_barrier(const XcdBarrier& b) {
    asm volatile("s_waitcnt vmcnt(0)" ::: "memory");
    __syncthreads();
    if (mk_tid() == 0) {
        unsigned* bar = b.bar;
        __builtin_amdgcn_s_waitcnt(0);
        unsigned nloc = b.st[0], nx = b.st[1];
        if (nloc == 0u) { xcd_barrier_complete(bar, b.x, nloc, nx); b.st[0] = nloc; b.st[1] = nx; }
        const unsigned old = xb_add(&bar[XB_XSUB(b.x)], 1u);
        const unsigned gen = old / nloc;
        if (old + 1u == (gen + 1u) * nloc) {
            __builtin_amdgcn_fence(__ATOMIC_RELEASE, "agent");
            asm volatile("s_waitcnt vmcnt(0)" ::: "memory");
            const unsigned og = xb_add(&bar[XB_TOP], 1u);
            const unsigned tg = og / nx;
            if (og + 1u == (tg + 1u) * nx) xb_add(&bar[XB_TOPGEN], 1u);
            else XB_SPIN(xb_ld(&bar[XB_TOPGEN]) == tg, bar);
            __builtin_amdgcn_fence(__ATOMIC_ACQUIRE, "agent");
            xb_add(&bar[XB_XGEN(b.x)], 1u);
            asm volatile("s_waitcnt vmcnt(0)" ::: "memory");
        } else {
            XB_SPIN(xb_ld(&bar[XB_XGEN(b.x)]) == gen, bar);
            __builtin_amdgcn_fence(__ATOMIC_ACQUIRE, "agent");
            asm volatile("s_waitcnt vmcnt(0)" ::: "memory");
        }
    }
    __syncthreads();
}
__device__ __forceinline__ void transpose_item(const float* srcA, const float* srcB, int ld_src, bf16* dst, int ld_dst, const float* scale, LAS float* scr, int lane) {
    f32x2 v[32]; const int n2 = lane & 31; const float* sp = (n2 < 16 ? srcA + 2 * n2 : srcB + 2 * (n2 - 16)) + (size_t)(lane >> 5) * ld_src;
#pragma unroll
    for (int i = 0; i < 32; ++i) v[i] = *(const f32x2*)(sp + (size_t)(2 * i) * ld_src);
    if (scale) {
#pragma unroll
        for (int i = 0; i < 32; ++i) { const float s = scale[2 * i + (lane >> 5)]; v[i] = v[i] * s; }
    }
#pragma unroll
    for (int i = 0; i < 32; ++i) { const int kk = 2 * i + (lane >> 5); scr[kk * 65 + 2 * n2] = v[i].x; scr[kk * 65 + 2 * n2 + 1] = v[i].y; }
    LDS_WAIT(); asm volatile("" ::: "memory");
    const int c = lane & 7;
#pragma unroll
    for (int j = 0; j < 8; ++j) { const int n = (lane >> 3) + 8 * j; const LAS float* s = scr + (8 * c) * 65 + n;
        u32x4 o; o.x = pk2(s[0 * 65], s[1 * 65]); o.y = pk2(s[2 * 65], s[3 * 65]); o.z = pk2(s[4 * 65], s[5 * 65]); o.w = pk2(s[6 * 65], s[7 * 65]);
        *(u32x4*)(dst + (size_t)n * ld_dst + 8 * c) = o; }
    LDS_WAIT(); asm volatile("" ::: "memory");
}
__device__ __forceinline__ void split8(const float (&x)[8], u32x4& h, u32x4& lo) {
    h.x = pk2(x[0], x[1]); h.y = pk2(x[2], x[3]); h.z = pk2(x[4], x[5]); h.w = pk2(x[6], x[7]);
    lo.x = pk2(x[0] - bflo(h.x), x[1] - bfhi(h.x)); lo.y = pk2(x[2] - bflo(h.y), x[3] - bfhi(h.y)); lo.z = pk2(x[4] - bflo(h.z), x[5] - bfhi(h.z)); lo.w = pk2(x[6] - bflo(h.w), x[7] - bfhi(h.w));
}
__device__ __forceinline__ void hyena_ktime_tile(const Args& a, int l, Frame& F, int tile) {
    typedef short bf16x8_t __attribute__((ext_vector_type(8)));
    typedef float f32x16_t __attribute__((ext_vector_type(16)));
    LAS float* featS = (LAS float*)F.lds;
    LAS float* h1s = featS + 64 * 33;
    LAS float* h2s = h1s + 64 * 65 + 3;
    LAS float* w1s = (LAS float*)F.lds + 6276 + 64 * 68;
    LAS float* w2s = w1s + 33 * 64;
    h2s = (LAS float*)F.lds + 6276;
    const float* w1 = a.in[I_HW1] + l * 33 * 64; const float* b1 = a.in[I_HB1] + l * 64; const float* f1 = a.in[I_HF1] + l * 64;
    const float* w2 = a.in[I_HW2] + l * 64 * 64; const float* b2 = a.in[I_HB2] + l * 64; const float* f2 = a.in[I_HF2] + l * 64;
    const float* w3 = a.in[I_HW3] + (size_t)l * 64 * 2048;
    float* KT = (float*)(a.ws + WS_KT);
    const int t0 = tile * 64, tid = F.tid, lane = F.lane, wave = F.wave;
    for (int i = tid; i < 33 * 64; i += NTHR) w1s[i] = w1[i];
    for (int i = tid; i < 64 * 64; i += NTHR) w2s[i] = w2[i];
    { const int t = tid >> 3, bb = (tid & 7) * 2; const float tn = (float)(t0 + t) / (float)SEQ;
      if ((tid & 7) == 0) featS[t * 33] = tn;
#pragma unroll
      for (int i = 0; i < 2; ++i) { const int b = bb + i; const float band = 1e-4f + (15.0f - 1e-4f) * ((float)b / 15.0f); const float ang = (6.283185307179586f * tn) * band;
          featS[t * 33 + 1 + b] = cosf(ang); featS[t * 33 + 17 + b] = -sinf(ang); } }
    __syncthreads();
    { const int t = tid >> 3, j0 = (tid & 7) * 8; float z[8];
#pragma unroll
      for (int j = 0; j < 8; ++j) z[j] = b1[j0 + j];
#pragma unroll 3
      for (int f = 0; f < 33; ++f) { const float x = featS[t * 33 + f]; const f32x4 wa = *(const LAS f32x4*)(w1s + f * 64 + j0), wb = *(const LAS f32x4*)(w1s + f * 64 + j0 + 4);
          z[0] += x * wa[0]; z[1] += x * wa[1]; z[2] += x * wa[2]; z[3] += x * wa[3]; z[4] += x * wb[0]; z[5] += x * wb[1]; z[6] += x * wb[2]; z[7] += x * wb[3]; }
#pragma unroll
      for (int j = 0; j < 8; ++j) h1s[t * 65 + j0 + j] = sinf(f1[j0 + j] * z[j]); }
    __syncthreads();
    { const int t = tid >> 3, j0 = (tid & 7) * 8; float z[8];
#pragma unroll
      for (int j = 0; j < 8; ++j) z[j] = b2[j0 + j];
#pragma unroll 4
      for (int f = 0; f < 64; ++f) { const float x = h1s[t * 65 + f]; const f32x4 wa = *(const LAS f32x4*)(w2s + f * 64 + j0), wb = *(const LAS f32x4*)(w2s + f * 64 + j0 + 4);
          z[0] += x * wa[0]; z[1] += x * wa[1]; z[2] += x * wa[2]; z[3] += x * wa[3]; z[4] += x * wb[0]; z[5] += x * wb[1]; z[6] += x * wb[2]; z[7] += x * wb[3]; }
#pragma unroll
      for (int j = 0; j < 8; ++j) h2s[t * 68 + j0 + j] = sinf(f2[j0 + j] * z[j]); }
    __syncthreads();
    const int r = lane & 31, h = lane >> 5;
    u32x4 ah[2][4], al[2][4];
#pragma unroll
    for (int rb = 0; rb < 2; ++rb)
#pragma unroll
        for (int ks = 0; ks < 4; ++ks) { const LAS float* p = h2s + (32 * rb + r) * 68 + 16 * ks + 8 * h; const f32x4 x0 = *(const LAS f32x4*)p, x1 = *(const LAS f32x4*)(p + 4);
            const float x[8] = {x0[0], x0[1], x0[2], x0[3], x1[0], x1[1], x1[2], x1[3]}; split8(x, ah[rb][ks], al[rb][ks]); }
    const float dA = -3.0701134573253943f, dB = -15.350567286626973f;
#pragma unroll 1
    for (int cb = 0; cb < 8; ++cb) { const int c = wave * 256 + cb * 32 + r;
        float wv[4][8];
#pragma unroll
        for (int ks = 0; ks < 4; ++ks)
#pragma unroll
            for (int j = 0; j < 8; ++j) wv[ks][j] = w3[(size_t)(16 * ks + 8 * h + j) * 2048 + c];
        f32x16_t acc0 = {}, acc1 = {};
#pragma unroll
        for (int ks = 0; ks < 4; ++ks) { u32x4 bh, bl; split8(wv[ks], bh, bl);
            const bf16x8_t Bh = __builtin_bit_cast(bf16x8_t, bh), Bl = __builtin_bit_cast(bf16x8_t, bl);
            acc0 = __builtin_amdgcn_mfma_f32_32x32x16_bf16(__builtin_bit_cast(bf16x8_t, al[0][ks]), Bh, acc0, 0, 0, 0);
            acc0 = __builtin_amdgcn_mfma_f32_32x32x16_bf16(__builtin_bit_cast(bf16x8_t, ah[0][ks]), Bl, acc0, 0, 0, 0);
            acc0 = __builtin_amdgcn_mfma_f32_32x32x16_bf16(__builtin_bit_cast(bf16x8_t, ah[0][ks]), Bh, acc0, 0, 0, 0);
            acc1 = __builtin_amdgcn_mfma_f32_32x32x16_bf16(__builtin_bit_cast(bf16x8_t, al[1][ks]), Bh, acc1, 0, 0, 0);
            acc1 = __builtin_amdgcn_mfma_f32_32x32x16_bf16(__builtin_bit_cast(bf16x8_t, ah[1][ks]), Bl, acc1, 0, 0, 0);
            acc1 = __builtin_amdgcn_mfma_f32_32x32x16_bf16(__builtin_bit_cast(bf16x8_t, ah[1][ks]), Bh, acc1, 0, 0, 0); }
        const float delta = fabsf(dA + (dB - dA) * ((float)(c & 511) / 511.0f)); float* dst = KT + (size_t)c * SEQ + t0 + 4 * h;
#pragma unroll
        for (int g = 0; g < 4; ++g) { f32x4 o0, o1;
#pragma unroll
            for (int j = 0; j < 4; ++j) { const float tn0 = (float)(t0 + 8 * g + 4 * h + j) / (float)SEQ, tn1 = (float)(t0 + 32 + 8 * g + 4 * h + j) / (float)SEQ;
                o0[j] = acc0[4 * g + j] * expf(-tn0 * delta); o1[j] = acc1[4 * g + j] * expf(-tn1 * delta); }
            *(f32x4*)(dst + 8 * g) = o0; *(f32x4*)(dst + 32 + 8 * g) = o1; }
        asm volatile("" ::: "memory");
    }
    __syncthreads();
}
__device__ __forceinline__ void ph_prologue(const Args& a, int l, Frame& F) {
    unsigned char* ws = a.ws;
#ifndef NO_KT
#ifndef KT_REP
#define KT_REP 1
#endif
    for (int rep_ = 0; rep_ < KT_REP; ++rep_)
    for (int tile = F.bid; tile < SEQ / 64; tile += F.G) hyena_ktime_tile(a, l, F, tile);
#endif
    LAS float* scr = (LAS float*)(F.lds + F.wave * 16640);
    constexpr int SA = 32 * 61, SB = 8 * 24, SC = 4 * 32, SD = 32 * 32, SE = 64 * 32 * 16, SF = 64 * 8 * 32, NITEMS = SA + SB + SC + SD + SE + SF;
    const float* w_in = a.in[I_WIN] + (size_t)l * DM * INW; const float* w_uq = a.in[I_WUQ] + (size_t)l * 512 * 1536; const float* w_ukv = a.in[I_WUKV] + (size_t)l * 256 * 2048;
    const float* w_out = a.in[I_WOUT] + (size_t)l * 2048 * 2048; const float* eg = a.in[I_EG] + (size_t)l * NEXP * 2048 * 512; const float* eu = a.in[I_EU] + (size_t)l * NEXP * 2048 * 512;
    const float* ed = a.in[I_ED] + (size_t)l * NEXP * 512 * 2048;
    bf16* WIN = (bf16*)(ws + WS_WIN); bf16* WUQ = (bf16*)(ws + WS_WUQ); bf16* WUKV = (bf16*)(ws + WS_WUKV); bf16* WOUT = (bf16*)(ws + WS_WOUT); bf16* WGU = (bf16*)(ws + WS_WGU); bf16* WDN = (bf16*)(ws + WS_WDN);
#ifndef NO_TR
#ifndef PRO_REP
#define PRO_REP 1
#endif
    for (int rep_ = 0; rep_ < PRO_REP; ++rep_)
    for (int it = F.gw; it < NITEMS; it += F.NGW) {
        int r = it; const float* srcA; const float* srcB; const float* scl = nullptr; bf16* dst; int lds_, ldd;
        if (r < SA) { const int kb = r / 61, nb = r % 61, k0 = 64 * kb, n0 = 64 * nb; srcA = w_in + (size_t)k0 * INW + n0; srcB = srcA + 32; lds_ = INW; dst = WIN + (size_t)n0 * 2048 + k0; ldd = 2048; }
        else if ((r -= SA) < SB) { const int kb = r / 24, nb = r % 24, k0 = 64 * kb, n0 = 64 * nb; int col[2];
#pragma unroll
            for (int hf = 0; hf < 2; ++hf) { const int nn = n0 + 32 * hf;
                if (nn < 1024) col[hf] = (nn >> 7) * 192 + (nn & 127);
                else { const int w = nn - 1024, tile = w >> 8, ww = w & 255, half = ww >> 7, hh = (ww & 127) >> 5; col[hf] = (tile * 4 + hh) * 192 + 128 + half * 32; } }
            srcA = w_uq + (size_t)k0 * 1536 + col[0]; srcB = w_uq + (size_t)k0 * 1536 + col[1]; lds_ = 1536; dst = WUQ + (size_t)n0 * 512 + k0; ldd = 512; scl = a.in[I_QG] + l * 512 + k0; }
        else if ((r -= SB) < SC) { const int kb = r / 32, nb = r % 32, k0 = 64 * kb, n0 = 64 * nb; const int col = n0 < 1024 ? (n0 >> 7) * 256 + (n0 & 127) : ((n0 - 1024) >> 7) * 256 + 128 + ((n0 - 1024) & 127);
            srcA = w_ukv + (size_t)k0 * 2048 + col; srcB = srcA + 32; lds_ = 2048; dst = WUKV + (size_t)n0 * 256 + k0; ldd = 256; scl = a.in[I_KVG] + l * 256 + k0; }
        else if ((r -= SC) < SD) { const int kb = r / 32, nb = r % 32, k0 = 64 * kb, n0 = 64 * nb; srcA = w_out + (size_t)k0 * 2048 + n0; srcB = srcA + 32; lds_ = 2048; dst = WOUT + (size_t)n0 * 2048 + k0; ldd = 2048; scl = a.in[I_GRPG] + l * 2048 + k0; }
        else if ((r -= SD) < SE) { const int e = r >> 9, rr = r & 511, kb = rr >> 4, nb = rr & 15, k0 = 64 * kb, n0 = 64 * nb, tile = n0 >> 8, ww = n0 & 255;
            srcA = (ww < 128 ? eg : eu) + (size_t)e * 2048 * 512 + (size_t)k0 * 512 + tile * 128 + (ww & 127); srcB = srcA + 32; lds_ = 512; dst = WGU + ((size_t)e * 1024 + n0) * 2048 + k0; ldd = 2048; }
        else { r -= SE; const int e = r >> 8, rr = r & 255, kb = rr >> 5, nb = rr & 31, k0 = 64 * kb, n0 = 64 * nb;
            srcA = ed + (size_t)e * 512 * 2048 + (size_t)k0 * 2048 + n0; srcB = srcA + 32; lds_ = 2048; dst = WDN + ((size_t)e * 2048 + n0) * 512 + k0; ldd = 512; }
        transpose_item(srcA, srcB, lds_, dst, ldd, scl, scr, F.lane);
    }
#endif
    { u32x4* z = (u32x4*)(WIN + (size_t)INW * 2048); unsigned z0 = 0u; asm volatile("" : "+v"(z0)); const u32x4 zero = {z0, z0, z0, z0};
      for (int i = F.bid * NTHR + F.tid; i < 192 * 2048 / 8; i += F.G * NTHR) z[i] = zero; }
#ifndef NO_MISC
    if (l == 0) {
        { const f32x4* x4 = (const f32x4*)a.in[I_X]; u32x4* o = (u32x4*)(ws + WS_XB);
          for (size_t i = (size_t)F.bid * NTHR + F.tid; i < (size_t)T * DM / 8; i += (size_t)F.G * NTHR) { const f32x4 p = x4[2 * i], q = x4[2 * i + 1]; o[i] = pg8::pack8(p, q); } }
        { float* cosT = (float*)(ws + WS_ROPE); float* sinT = cosT + SEQ * 32;
          for (int i = F.bid * NTHR + F.tid; i < SEQ * 32; i += F.G * NTHR) { const int pos = i >> 5, f = i & 31; const float inv = powf(10000.0f, -(float)(2 * f) / 64.0f); const float ang = (float)pos * inv; cosT[i] = cosf(ang); sinT[i] = sinf(ang); } }
        { f32x2* TW = (f32x2*)(ws + WS_TW);
          for (int i = F.bid * NTHR + F.tid; i < 16384; i += F.G * NTHR) { float s, c; sincospif((float)i / 16384.0f, &s, &c); TW[i] = (f32x2){c, -s}; } }
        { f32x2* TWP = (f32x2*)(ws + WS_TWP);
          for (int u = F.bid * NTHR + F.tid; u < 8192; u += F.G * NTHR) { const int uu = u == 0 ? 1 : u; const int jb = 31 - __clz(uu), pp_ = (2 << jb) + (uu - (1 << jb)), k = (int)(__brev((unsigned)pp_) >> 18);
              float s, c; sincospif((float)k / 16384.0f, &s, &c); TWP[u] = (f32x2){c, -s}; } }
        { u32x4* WRB = (u32x4*)(ws + WS_WR); const float* rw = a.in[I_RW];
          for (int i = F.bid * NTHR + F.tid; i < 64 * 4 * 64; i += F.G * NTHR) { const int ln = i & 63, nt = (i >> 6) & 3, ks = i >> 8, n = ln & 15, q = ln >> 4; float w[8], wl[8];
#pragma unroll
              for (int j = 0; j < 8; ++j) { w[j] = rw[(size_t)(32 * ks + 8 * q + j) * 64 + 16 * nt + n]; }
              u32x4 h; h.x = pk2(w[0], w[1]); h.y = pk2(w[2], w[3]); h.z = pk2(w[4], w[5]); h.w = pk2(w[6], w[7]);
              wl[0] = w[0] - bflo(h.x); wl[1] = w[1] - bfhi(h.x); wl[2] = w[2] - bflo(h.y); wl[3] = w[3] - bfhi(h.y); wl[4] = w[4] - bflo(h.z); wl[5] = w[5] - bfhi(h.z); wl[6] = w[6] - bflo(h.w); wl[7] = w[7] - bfhi(h.w);
              u32x4 lo; lo.x = pk2(wl[0], wl[1]); lo.y = pk2(wl[2], wl[3]); lo.z = pk2(wl[4], wl[5]); lo.w = pk2(wl[6], wl[7]);
              WRB[((ks * 4 + nt) * 2 + 0) * 64 + ln] = h; WRB[((ks * 4 + nt) * 2 + 1) * 64 + ln] = lo; } }
    }
#endif
}
__device__ __forceinline__ void ph_postproj_waveitems(const Args& a, int l, Frame& F) {
    unsigned char* ws = a.ws; const int lane = F.lane;
    { const bf16* U = (const bf16*)(ws + WS_U); bf16* UT = (bf16*)(ws + WS_UT); LAS bf16* scr = (LAS bf16*)(F.lds + F.wave * 8704);
      for (int it = F.gw; it < (T / 64) * 24; it += F.NGW) { const int tt = it / 24, cb = it % 24, row0 = tt * 64, c0 = cb * 64, b = row0 / SEQ, ts0 = row0 % SEQ;
#pragma unroll
          for (int i = 0; i < 8; ++i) { const int t = (lane >> 3) + 8 * i, pc = lane & 7; const u32x4 v = *(const u32x4*)(U + (size_t)(row0 + t) * 1536 + c0 + 8 * pc);
              LAS unsigned* d = (LAS unsigned*)(scr + t * 68 + 8 * pc); d[0] = v.x; d[1] = v.y; d[2] = v.z; d[3] = v.w; }
          LDS_WAIT(); asm volatile("" ::: "memory");
#pragma unroll
          for (int i = 0; i < 8; ++i) { const int c = (lane >> 3) + 8 * i, tp = lane & 7; unsigned short e[8];
#pragma unroll
              for (int j = 0; j < 8; ++j) e[j] = scr[(8 * tp + j) * 68 + c];
              u32x4 o; o.x = e[0] | ((unsigned)e[1] << 16); o.y = e[2] | ((unsigned)e[3] << 16); o.z = e[4] | ((unsigned)e[5] << 16); o.w = e[6] | ((unsigned)e[7] << 16);
              *(u32x4*)(UT + ((size_t)b * 1536 + c0 + c) * SEQ + ts0 + 8 * tp) = o; }
          LDS_WAIT(); asm volatile("" ::: "memory"); } }
    { const bf16* CQ = (const bf16*)(ws + WS_CQ); const bf16* CKV = (const bf16*)(ws + WS_CKV); float* RQ = (float*)(ws + WS_RQ); float* RKV = (float*)(ws + WS_RKV);
      for (int row0 = 4 * F.gw; row0 < T; row0 += 4 * F.NGW) { u32x4 v[4]; u32x2 v2[4];
#pragma unroll
          for (int i = 0; i < 4; ++i) { v[i] = *(const u32x4*)(CQ + (size_t)(row0 + i) * 512 + 8 * lane); v2[i] = *(const u32x2*)(CKV + (size_t)(row0 + i) * 256 + 4 * lane); }
          float s[4], s2[4];
#pragma unroll
          for (int i = 0; i < 4; ++i) { const unsigned w[4] = {v[i].x, v[i].y, v[i].z, v[i].w}; float acc = 0.f;
#pragma unroll
              for (int j = 0; j < 4; ++j) { const float x0 = bflo(w[j]), x1 = bfhi(w[j]); acc += x0 * x0 + x1 * x1; }
              s[i] = acc; const float y0 = bflo(v2[i].x), y1 = bfhi(v2[i].x), y2 = bflo(v2[i].y), y3 = bfhi(v2[i].y); s2[i] = y0 * y0 + y1 * y1 + y2 * y2 + y3 * y3; }
#pragma unroll
          for (int o = 1; o < 64; o <<= 1) {
#pragma unroll
              for (int i = 0; i < 4; ++i) { s[i] += shx(s[i], o, lane); s2[i] += shx(s2[i], o, lane); } }
          if (lane < 4) { const float a0 = lane == 0 ? s[0] : lane == 1 ? s[1] : lane == 2 ? s[2] : s[3], a1 = lane == 0 ? s2[0] : lane == 1 ? s2[1] : lane == 2 ? s2[2] : s2[3];
              RQ[row0 + lane] = 1.0f / sqrtf(a0 * (1.0f / 512.0f) + LN_EPS); RKV[row0 + lane] = 1.0f / sqrtf(a1 * (1.0f / 256.0f) + LN_EPS); } } }
    { const bf16* KR = (const bf16*)(ws + WS_KR); bf16* KROT = (bf16*)(ws + WS_KROT); const float* cosT = (const float*)(ws + WS_ROPE); const float* sinT = cosT + SEQ * 32;
      for (int i = F.bid * NTHR + F.tid; i < T * 4; i += F.G * NTHR) { const int row = i >> 2, d0 = (i & 3) * 8, pos = row & (SEQ - 1);
          const u32x4 a1 = *(const u32x4*)(KR + (size_t)row * 64 + d0), a2 = *(const u32x4*)(KR + (size_t)row * 64 + 32 + d0);
          const f32x4 c0 = *(const f32x4*)(cosT + pos * 32 + d0), c1 = *(const f32x4*)(cosT + pos * 32 + d0 + 4), s0 = *(const f32x4*)(sinT + pos * 32 + d0), s1 = *(const f32x4*)(sinT + pos * 32 + d0 + 4);
          const f32x4 x1a = {bflo(a1.x), bfhi(a1.x), bflo(a1.y), bfhi(a1.y)}, x1b = {bflo(a1.z), bfhi(a1.z), bflo(a1.w), bfhi(a1.w)};
          const f32x4 x2a = {bflo(a2.x), bfhi(a2.x), bflo(a2.y), bfhi(a2.y)}, x2b = {bflo(a2.z), bfhi(a2.z), bflo(a2.w), bfhi(a2.w)};
          *(u32x4*)(KROT + (size_t)row * 64 + d0) = pg8::pack8(x1a * c0 - x2a * s0, x1b * c1 - x2b * s1);
          *(u32x4*)(KROT + (size_t)row * 64 + 32 + d0) = pg8::pack8(x1a * s0 + x2a * c0, x1b * s1 + x2b * c1); } }
}
__device__ __forceinline__ float ssq8(const u32x4 v) { float s = 0.f; const unsigned w[4] = {v.x, v.y, v.z, v.w};
#pragma unroll
    for (int j = 0; j < 4; ++j) { const float x0 = bflo(w[j]), x1 = bfhi(w[j]); s += x0 * x0 + x1 * x1; } return s; }
__device__ __forceinline__ u32x4 scale8(const u32x4 v, float r) { u32x4 o; o.x = pk2(bflo(v.x) * r, bfhi(v.x) * r); o.y = pk2(bflo(v.y) * r, bfhi(v.y) * r); o.z = pk2(bflo(v.z) * r, bfhi(v.z) * r); o.w = pk2(bflo(v.w) * r, bfhi(v.w) * r); return o; }
__device__ __forceinline__ void ph_groupnorm(const Args& a, Frame& F) {
    unsigned char* ws = a.ws; const bf16* Y = (const bf16*)(ws + WS_Y); const bf16* YT = (const bf16*)(ws + WS_YT); bf16* MIX = (bf16*)(ws + WS_MIX);
    LAS bf16* hyS = (LAS bf16*)F.lds;
    for (int unit = F.bid; unit < T / 64; unit += F.G) { const int row0 = unit * 64, b = row0 / SEQ, ts0 = row0 % SEQ;
        { const int cr = F.tid >> 3, ch = F.tid & 7;
#pragma unroll
          for (int i = 0; i < 8; ++i) { const int c = cr + 64 * i; const u32x4 v = *(const u32x4*)(YT + ((size_t)b * 512 + c) * SEQ + ts0 + 8 * ch); const unsigned w[4] = {v.x, v.y, v.z, v.w};
#pragma unroll
              for (int j = 0; j < 4; ++j) { hyS[(8 * ch + 2 * j) * 520 + c] = (bf16)(w[j] & 0xffffu); hyS[(8 * ch + 2 * j + 1) * 520 + c] = (bf16)(w[j] >> 16); } } }
        __syncthreads();
        for (int i0 = 0; i0 < 8; i0 += 4) { const int lane = F.lane; u32x4 hy[4], na[4], m0[4], m1[4];
#pragma unroll
            for (int i = 0; i < 4; ++i) { const int t = F.wave * 8 + i0 + i, row = row0 + t;
                na[i] = *(const u32x4*)(Y + (size_t)row * 1536 + 8 * lane); m0[i] = *(const u32x4*)(Y + (size_t)row * 1536 + 512 + 8 * lane); m1[i] = *(const u32x4*)(Y + (size_t)row * 1536 + 1024 + 8 * lane);
                hy[i] = *(const LAS u32x4*)(hyS + t * 520 + 8 * lane); }
            float sh[4], sn[4], sm[4];
#pragma unroll
            for (int i = 0; i < 4; ++i) { sh[i] = ssq8(hy[i]); sn[i] = ssq8(na[i]); sm[i] = ssq8(m0[i]) + ssq8(m1[i]); }
#pragma unroll
            for (int o = 1; o < 64; o <<= 1) {
#pragma unroll
                for (int i = 0; i < 4; ++i) { sh[i] += shx(sh[i], o, lane); sn[i] += shx(sn[i], o, lane); sm[i] += shx(sm[i], o, lane); } }
#pragma unroll
            for (int i = 0; i < 4; ++i) { const int row = row0 + F.wave * 8 + i0 + i;
                const float rh = 1.0f / sqrtf(sh[i] * (1.0f / 512.0f) + LN_EPS), rn = 1.0f / sqrtf(sn[i] * (1.0f / 512.0f) + LN_EPS), rm = 1.0f / sqrtf(sm[i] * (1.0f / 1024.0f) + LN_EPS);
                bf16* o = MIX + (size_t)row * 2048 + 8 * lane;
                *(u32x4*)o = scale8(hy[i], rh); *(u32x4*)(o + 512) = scale8(na[i], rn); *(u32x4*)(o + 1024) = scale8(m0[i], rm); *(u32x4*)(o + 1536) = scale8(m1[i], rm); } }
        __syncthreads();
    }
}
__device__ __forceinline__ void ph_router(const Args& a, int l, Frame& F, int rep = 0) {
    unsigned char* ws = a.ws; const bf16* H1 = (const bf16*)(ws + WS_H1); const f32x2* part = (const f32x2*)(ws + WS_PART);
    const float* g1 = a.in[I_LN1G] + l * DM; const float* b1 = a.in[I_LN1B] + l * DM; const u32x4* WRB = (const u32x4*)(ws + WS_WR); const float* rb = a.in[I_RB];
    unsigned* cnt = (unsigned*)(ws + WS_CTL) + CW_CNT + 64 * (l + 2 * rep) * CNT_STRIDE; u32x2* tabE = (u32x2*)(ws + WS_TABE) + (size_t)rep * 64 * T; bf16* XM = (bf16*)(ws + WS_XM) + (size_t)rep * T * DM;
    typedef short bf16x8_t __attribute__((ext_vector_type(8)));
    LAS u32x4* Bs = (LAS u32x4*)F.lds;
    LAS float* lg = (LAS float*)(F.lds + F.wave * 4352);
    const int lane = F.lane, r = lane & 15, q = lane >> 4, tid = F.tid;
    if (tid < 64) ((LAS unsigned*)(F.lds + LC_TP))[tid] = 0u;
    LAS float* gS = (LAS float*)(F.lds + 131072); LAS float* bS = gS + DM;
    for (int i = tid; i < DM; i += NTHR) { gS[i] = g1[i]; bS[i] = b1[i]; }
    __syncthreads();
    for (int unit = F.bid; unit < T / 128; unit += F.G) { const int row0 = unit * 128 + F.wave * 16;
        float s = 0.f, sq = 0.f;
#pragma unroll
        for (int i = 0; i < 8; ++i) { const f32x2 pp = part[(size_t)(row0 + r) * 32 + 8 * q + i]; s += pp.x; sq += pp.y; }
        s += shx(s, 16, lane); s += shx(s, 32, lane); sq += shx(sq, 16, lane); sq += shx(sq, 32, lane);
        const float mean = s * (1.0f / DM), var = sq * (1.0f / DM) - mean * mean, rstd = 1.0f / sqrtf(var + LN_EPS);
        f32x4 acc[4];
#pragma unroll
        for (int nt = 0; nt < 4; ++nt) acc[nt] = (f32x4){0.f, 0.f, 0.f, 0.f};
        const bf16* hrow = H1 + (size_t)(row0 + r) * DM + 8 * q;
        u32x4 st[8];
#pragma unroll
        for (int j = 0; j < 8; ++j) st[j] = WRB[tid + NTHR * j];
#pragma unroll
        for (int j = 0; j < 8; ++j) Bs[tid + NTHR * j] = st[j];
        u32x4 hv[8];
#pragma unroll
        for (int ks = 0; ks < 8; ++ks) hv[ks] = *(const u32x4*)(hrow + 32 * ks);
        __syncthreads();
#pragma unroll 1
        for (int c = 0; c < 8; ++c) { const LAS u32x4* Bc = Bs + (c & 1) * 4096; u32x4 hn[8];
            if (c + 1 < 8) {
#pragma unroll
                for (int j = 0; j < 8; ++j) st[j] = WRB[(c + 1) * 4096 + tid + NTHR * j];
#pragma unroll
                for (int ks = 0; ks < 8; ++ks) hn[ks] = *(const u32x4*)(hrow + 32 * (8 * (c + 1) + ks)); }
#pragma unroll
            for (int ks = 0; ks < 8; ++ks) { const int kk = 32 * (8 * c + ks), k = kk + 8 * q;
                const u32x4 hw_ = hv[ks]; const f32x4 h0 = {bflo(hw_.x), bfhi(hw_.x), bflo(hw_.y), bfhi(hw_.y)}, h1 = {bflo(hw_.z), bfhi(hw_.z), bflo(hw_.w), bfhi(hw_.w)};
                const f32x4 ga = *(const LAS f32x4*)(gS + k), gb = *(const LAS f32x4*)(gS + k + 4), ba = *(const LAS f32x4*)(bS + k), bb = *(const LAS f32x4*)(bS + k + 4);
                const f32x4 x0 = (h0 - mean) * rstd * ga + ba, x1 = (h1 - mean) * rstd * gb + bb;
                u32x4 xh; xh.x = pk2(x0[0], x0[1]); xh.y = pk2(x0[2], x0[3]); xh.z = pk2(x1[0], x1[1]); xh.w = pk2(x1[2], x1[3]);
                *(u32x4*)(XM + (size_t)(row0 + r) * DM + k) = xh;
                u32x4 xl; xl.x = pk2(x0[0] - bflo(xh.x), x0[1] - bfhi(xh.x)); xl.y = pk2(x0[2] - bflo(xh.y), x0[3] - bfhi(xh.y)); xl.z = pk2(x1[0] - bflo(xh.z), x1[1] - bfhi(xh.z)); xl.w = pk2(x1[2] - bflo(xh.w), x1[3] - bfhi(xh.w));
                const bf16x8_t ah = __builtin_bit_cast(bf16x8_t, xh), al = __builtin_bit_cast(bf16x8_t, xl);
#pragma unroll
                for (int nt = 0; nt < 4; ++nt) { const bf16x8_t wh = __builtin_bit_cast(bf16x8_t, Bc[((ks * 4 + nt) * 2 + 0) * 64 + lane]), wl = __builtin_bit_cast(bf16x8_t, Bc[((ks * 4 + nt) * 2 + 1) * 64 + lane]);
                    acc[nt] = __builtin_amdgcn_mfma_f32_16x16x32_bf16(al, wh, acc[nt], 0, 0, 0);
                    acc[nt] = __builtin_amdgcn_mfma_f32_16x16x32_bf16(ah, wl, acc[nt], 0, 0, 0);
                    acc[nt] = __builtin_amdgcn_mfma_f32_16x16x32_bf16(ah, wh, acc[nt], 0, 0, 0); } }
            if (c + 1 < 8) { LAS u32x4* Bn = Bs + ((c + 1) & 1) * 4096;
#pragma unroll
                for (int j = 0; j < 8; ++j) Bn[tid + NTHR * j] = st[j];
#pragma unroll
                for (int ks = 0; ks < 8; ++ks) hv[ks] = hn[ks]; }
            __syncthreads();
        }
#pragma unroll
        for (int nt = 0; nt < 4; ++nt)
#pragma unroll
            for (int v = 0; v < 4; ++v) lg[(4 * q + v) * 65 + 16 * nt + r] = acc[nt][v];
        LDS_WAIT(); asm volatile("" ::: "memory");
        LAS unsigned* lcnt = (LAS unsigned*)(F.lds + LC_TP); LAS unsigned* lbase = lcnt + 64;
        int e0 = 0, e1 = 0; unsigned r0 = 0u, r1 = 0u; float gw0 = 0.f, gw1 = 0.f;
        if (lane < 16) { const LAS float* row = lg + lane * 65; float bestv = -1e30f; int best = 0;
            for (int g = 0; g < 8; ++g) { float m1 = -1e30f, m2 = -1e30f;
#pragma unroll
                for (int i = 0; i < 8; ++i) { const float sc = 1.0f / (1.0f + expf(-row[g * 8 + i])); const float sel = sc + rb[g * 8 + i]; if (sel > m1) { m2 = m1; m1 = sel; } else if (sel > m2) m2 = sel; }
                const float gs = m1 + m2; if (gs > bestv) { bestv = gs; best = g; } }
            float m1 = -1e30f, m2 = -1e30f, s1 = 0.f, s2 = 0.f; int i1 = 0, i2 = 0;
#pragma unroll
            for (int i = 0; i < 8; ++i) { const float sc = 1.0f / (1.0f + expf(-row[best * 8 + i])); const float sel = sc + rb[best * 8 + i];
                if (sel > m1) { m2 = m1; i2 = i1; s2 = s1; m1 = sel; i1 = i; s1 = sc; } else if (sel > m2) { m2 = sel; i2 = i; s2 = sc; } }
            e0 = best * 8 + i1; e1 = best * 8 + i2; const float inv = 1.0f / (s1 + s2); gw0 = s1 * inv; gw1 = s2 * inv;
            r0 = __hip_atomic_fetch_add(lcnt + e0, 1u, __ATOMIC_RELAXED, __HIP_MEMORY_SCOPE_WORKGROUP); r1 = __hip_atomic_fetch_add(lcnt + e1, 1u, __ATOMIC_RELAXED, __HIP_MEMORY_SCOPE_WORKGROUP); }
        __syncthreads();
        if (tid < 64) { const unsigned n = lcnt[tid]; unsigned b = 0u; if (n) b = __hip_atomic_fetch_add(cnt + tid * CNT_STRIDE, n, __ATOMIC_RELAXED, __HIP_MEMORY_SCOPE_AGENT); lbase[tid] = b; }
        __syncthreads();
        if (lane < 16) { const unsigned p0 = lbase[e0] + r0, p1 = lbase[e1] + r1;
            tabE[(size_t)e0 * T + p0] = (u32x2){(unsigned)(2 * (row0 + lane)), __float_as_uint(gw0)}; tabE[(size_t)e1 * T + p1] = (u32x2){(unsigned)(2 * (row0 + lane) + 1), __float_as_uint(gw1)}; }
        __syncthreads();
        if (tid < 64) lcnt[tid] = 0u;
        __syncthreads();
    }
}
__device__ __forceinline__ void moe_tables(const Args& a, int l, Frame& F) {
    const unsigned* cnt = (const unsigned*)(a.ws + WS_CTL) + CW_CNT + 64 * l * CNT_STRIDE;
    LAS int* tp = (LAS int*)(F.lds + LC_TP); LAS int* cs = (LAS int*)(F.lds + LC_CNT); LAS int* te = (LAS int*)(F.lds + LC_TILEE);
    if (F.tid < 64) { const int c = (int)__hip_atomic_load(cnt + F.tid * CNT_STRIDE, __ATOMIC_RELAXED, __HIP_MEMORY_SCOPE_AGENT); const int nt = (c + 255) >> 8; int incl = nt;
#pragma unroll
        for (int o = 1; o < 64; o <<= 1) { const int t = shup_i(incl, o, F.lane); if (F.lane >= o) incl += t; }
        tp[F.tid] = incl - nt; cs[F.tid] = c; if (F.tid == 63) tp[64] = incl;
        for (int i = incl - nt; i < incl; ++i) te[i] = F.tid; }
    __syncthreads();
}
__device__ __forceinline__ void ph_combine(const Args& a, int l, Frame& F) {
    unsigned char* ws = a.ws; const bf16* XM = (const bf16*)(ws + WS_XM);
    const float* g2 = a.in[I_LN2G] + l * DM; const float* b2 = a.in[I_LN2B] + l * DM;
    const bf16* FF = (const bf16*)(ws + WS_FF); float* out = a.out; bf16* XB = (bf16*)(ws + WS_XB); const int lane = F.lane;
    for (int row = 2 * F.gw; row < T; row += 2 * F.NGW) {
        u32x4 xr[2][4], a0[2][4], a1[2][4];
#pragma unroll
        for (int r = 0; r < 2; ++r) { const bf16* xm = XM + (size_t)(row + r) * DM + 8 * lane; const bf16* f0 = FF + (size_t)(2 * (row + r)) * DM + 8 * lane; const bf16* f1 = f0 + DM;
#pragma unroll
            for (int j = 0; j < 4; ++j) { xr[r][j] = *(const u32x4*)(xm + 512 * j); a0[r][j] = *(const u32x4*)(f0 + 512 * j); a1[r][j] = *(const u32x4*)(f1 + 512 * j); } }
#pragma unroll
        for (int r = 0; r < 2; ++r) {
            f32x4 v[8]; float s = 0.f;
#pragma unroll
            for (int j = 0; j < 4; ++j)
#pragma unroll
                for (int hh = 0; hh < 2; ++hh) { const unsigned x0 = hh ? xr[r][j].z : xr[r][j].x, x1 = hh ? xr[r][j].w : xr[r][j].y, p0 = hh ? a0[r][j].z : a0[r][j].x, p1 = hh ? a0[r][j].w : a0[r][j].y, q0 = hh ? a1[r][j].z : a1[r][j].x, q1 = hh ? a1[r][j].w : a1[r][j].y;
                    f32x4 x; x[0] = bflo(x0) * ALPHA + (bflo(p0) + bflo(q0)); x[1] = bfhi(x0) * ALPHA + (bfhi(p0) + bfhi(q0)); x[2] = bflo(x1) * ALPHA + (bflo(p1) + bflo(q1)); x[3] = bfhi(x1) * ALPHA + (bfhi(p1) + bfhi(q1));
                    v[2 * j + hh] = x; s += (x[0] + x[1]) + (x[2] + x[3]); }
            const float mean = wave_sum(s, lane) * (1.0f / DM); float q = 0.f;
#pragma unroll
            for (int j = 0; j < 8; ++j) { v[j] = v[j] - mean; q += (v[j][0] * v[j][0] + v[j][1] * v[j][1]) + (v[j][2] * v[j][2] + v[j][3] * v[j][3]); }
            const float rstd = 1.0f / sqrtf(wave_sum(q, lane) * (1.0f / DM) + LN_EPS);
#pragma unroll
            for (int j = 0; j < 4; ++j) { const int col = 8 * lane + 512 * j; f32x4 o[2];
#pragma unroll
                for (int hh = 0; hh < 2; ++hh) { const f32x4 g = *(const f32x4*)(g2 + col + 4 * hh), bb = *(const f32x4*)(b2 + col + 4 * hh); o[hh] = v[2 * j + hh] * rstd * g + bb;
                    if (l + 1 == NLAYER) *(f32x4*)(out + (size_t)(row + r) * DM + col + 4 * hh) = o[hh]; }
                if (l + 1 < NLAYER) *(u32x4*)(XB + (size_t)(row + r) * DM + col) = pg8::pack8(o[0], o[1]); }
        }
    }
}
namespace att {
using bf16x8 = __attribute__((ext_vector_type(8))) short;
using s16x4  = __attribute__((ext_vector_type(4))) short;
using f32x16 = __attribute__((ext_vector_type(16))) float;
#define SBAR() __builtin_amdgcn_sched_barrier(0)
__device__ __forceinline__ int crow(int r, int hi) { return (r & 3) + 8 * (r >> 2) + 4 * hi; }
__device__ __forceinline__ unsigned cvtpk(float lo, float hi) { unsigned r; asm volatile("v_cvt_pk_bf16_f32 %0, %1, %2" : "=v"(r) : "v"(lo), "v"(hi)); return r; }
constexpr float THR2 = 11.5f;
__device__ __forceinline__ void partialSM(f32x16& p0, f32x16& p1, float& m_reg, float& mn, float& alpha) {
  float pmax = p0[0];
#pragma unroll
  for (int r = 1; r < 16; ++r) pmax = fmaxf(pmax, p0[r]);
#pragma unroll
  for (int r = 0; r < 16; ++r) pmax = fmaxf(pmax, p1[r]);
  { auto rr = __builtin_amdgcn_permlane32_swap(__float_as_uint(pmax), __float_as_uint(pmax), false, false);
    pmax = fmaxf(__uint_as_float(rr[0]), __uint_as_float(rr[1])); }
  if (__builtin_expect(__all(pmax - m_reg <= THR2), 1)) { mn = m_reg; alpha = 1.f; }
  else { mn = fmaxf(m_reg, pmax); alpha = __builtin_amdgcn_exp2f(m_reg - mn); m_reg = mn; }
#pragma unroll
  for (int r = 0; r < 16; ++r) p0[r] = p0[r] - mn;
#pragma unroll
  for (int r = 0; r < 16; ++r) p1[r] = p1[r] - mn;
#pragma unroll
  for (int r = 0; r < 16; ++r) p0[r] = __builtin_amdgcn_exp2f(p0[r]);
}
__device__ __forceinline__ void finishSM(f32x16& p0, f32x16& p1, float alpha, float& l_reg, bf16x8& pa0, bf16x8& pa1, bf16x8& pa2, bf16x8& pa3) {
#pragma unroll
  for (int r = 0; r < 16; ++r) p1[r] = __builtin_amdgcn_exp2f(p1[r]);
  float ps = 0;
#pragma unroll
  for (int r = 0; r < 16; ++r) ps += p0[r];
#pragma unroll
  for (int r = 0; r < 16; ++r) ps += p1[r];
  { auto rr = __builtin_amdgcn_permlane32_swap(__float_as_uint(ps), __float_as_uint(ps), false, false);
    ps = __uint_as_float(rr[0]) + __uint_as_float(rr[1]); }
  l_reg = l_reg * alpha + ps;
#define PK4(P, BASE, OUT) do { unsigned a0 = cvtpk(P[BASE + 0], P[BASE + 1]), a1 = cvtpk(P[BASE + 2], P[BASE + 3]);   \
    unsigned b0 = cvtpk(P[BASE + 4], P[BASE + 5]), b1 = cvtpk(P[BASE + 6], P[BASE + 7]);                              \
    auto r0 = __builtin_amdgcn_permlane32_swap(a0, b0, false, false); auto r1 = __builtin_amdgcn_permlane32_swap(a1, b1, false, false); \
    u32x4 w = {r0[0], r1[0], r0[1], r1[1]}; OUT = *reinterpret_cast<bf16x8*>(&w); } while (0)
  PK4(p0, 0, pa0); PK4(p0, 8, pa1); PK4(p1, 0, pa2); PK4(p1, 8, pa3);
#undef PK4
}
template <int NCB> __device__ __forceinline__ int v_st(int k, int c) { const int kk = (k & ~0xC) | ((k & 4) << 1) | ((k & 8) >> 1); return ((kk >> 3) * NCB + (c >> 5)) * 512 + ((kk & 7) * 32 + (c & 31)) * 2; }
__device__ __forceinline__ int v_rd_base(int lane) { return ((lane & 3) << 3) | (((lane >> 2) & 3) << 6) | (((lane >> 4) & 1) << 5) | (((lane >> 5) & 1) << 8); }
template <int NCB> constexpr int v_rd_off(int d0, int ks, int half) { return d0 * 512 + ks * (1024 * NCB) + half * (512 * NCB); }
template <int OFF> __device__ __forceinline__ s16x4 tr_read(int vb) {
  s16x4 r; asm volatile("ds_read_b64_tr_b16 %0, %1 offset:%2" : "=&v"(r) : "v"(vb), "i"(OFF) : "memory"); return r;
}
template <int NCB, int D0> __device__ __forceinline__ void pv_one(f32x16& od, int vb, bf16x8 pa0, bf16x8 pa1, bf16x8 pa2, bf16x8 pa3) {
  const s16x4 l0 = tr_read<v_rd_off<NCB>(D0, 0, 0)>(vb), h0 = tr_read<v_rd_off<NCB>(D0, 0, 1)>(vb), l1 = tr_read<v_rd_off<NCB>(D0, 1, 0)>(vb), h1 = tr_read<v_rd_off<NCB>(D0, 1, 1)>(vb);
  const s16x4 l2 = tr_read<v_rd_off<NCB>(D0, 2, 0)>(vb), h2 = tr_read<v_rd_off<NCB>(D0, 2, 1)>(vb), l3 = tr_read<v_rd_off<NCB>(D0, 3, 0)>(vb), h3 = tr_read<v_rd_off<NCB>(D0, 3, 1)>(vb);
  asm volatile("s_waitcnt lgkmcnt(0)" ::: "memory"); SBAR();
#define PK(L, H) (bf16x8){L[0], L[1], L[2], L[3], H[0], H[1], H[2], H[3]}
  od = __builtin_amdgcn_mfma_f32_32x32x16_bf16(pa0, PK(l0, h0), od, 0, 0, 0);
  od = __builtin_amdgcn_mfma_f32_32x32x16_bf16(pa1, PK(l1, h1), od, 0, 0, 0);
  od = __builtin_amdgcn_mfma_f32_32x32x16_bf16(pa2, PK(l2, h2), od, 0, 0, 0);
  od = __builtin_amdgcn_mfma_f32_32x32x16_bf16(pa3, PK(l3, h3), od, 0, 0, 0);
#undef PK
}
constexpr int SHM_V = 16384, SHM_KN = 16384, SHM_KR = 8192;
constexpr int OFF_V = 0, OFF_KN = 2 * SHM_V, OFF_KR = OFF_KN + 2 * SHM_KN, OFF_WS = OFF_KR + 2 * SHM_KR, OFF_QR = OFF_WS + NWAVES * 256, MLA_LDS = OFF_QR + NWAVES * 4096;
#define KNSWZ(row, colB) ((row) * 256 + ((colB) ^ (((row) & 15) << 4)))
#define KRSWZ(row, colB) ((row) * 128 + ((colB) ^ ((((row) >> 1) & 7) << 4)))
__device__ __forceinline__ void qkt_mla(f32x16& p0, f32x16& p1, const char* Kn, const char* Kr, const bf16x8* qr, const char* qrot, int r32, int hi) {
  p0 = f32x16{}; p1 = f32x16{};
  __builtin_amdgcn_s_setprio(1);
#pragma unroll
  for (int d0 = 0; d0 < 8; ++d0) { const int cb = (d0 * 16 + hi * 8) * 2;
    const bf16x8 b0 = *reinterpret_cast<const bf16x8*>(Kn + KNSWZ(r32, cb));
    const bf16x8 b1 = *reinterpret_cast<const bf16x8*>(Kn + KNSWZ(32 + r32, cb));
    p0 = __builtin_amdgcn_mfma_f32_32x32x16_bf16(b0, qr[d0], p0, 0, 0, 0);
    p1 = __builtin_amdgcn_mfma_f32_32x32x16_bf16(b1, qr[d0], p1, 0, 0, 0); }
#pragma unroll
  for (int d0 = 0; d0 < 4; ++d0) { const int cb = (d0 * 16 + hi * 8) * 2;
    const bf16x8 b0 = *reinterpret_cast<const bf16x8*>(Kr + KRSWZ(r32, cb));
    const bf16x8 b1 = *reinterpret_cast<const bf16x8*>(Kr + KRSWZ(32 + r32, cb));
    const bf16x8 q = *reinterpret_cast<const bf16x8*>(qrot + d0 * 1024);
    p0 = __builtin_amdgcn_mfma_f32_32x32x16_bf16(b0, q, p0, 0, 0, 0);
    p1 = __builtin_amdgcn_mfma_f32_32x32x16_bf16(b1, q, p1, 0, 0, 0); }
  __builtin_amdgcn_s_setprio(0);
}
__device__ __forceinline__ void qkt_mla_r(f32x16& p0, f32x16& p1, const char* Kn, const char* Kr, const bf16x8* qr, int r32, int hi) {
  p0 = f32x16{}; p1 = f32x16{};
  __builtin_amdgcn_s_setprio(1);
#pragma unroll
  for (int d0 = 0; d0 < 8; ++d0) { const int cb = (d0 * 16 + hi * 8) * 2;
    const bf16x8 b0 = *reinterpret_cast<const bf16x8*>(Kn + KNSWZ(r32, cb));
    const bf16x8 b1 = *reinterpret_cast<const bf16x8*>(Kn + KNSWZ(32 + r32, cb));
    p0 = __builtin_amdgcn_mfma_f32_32x32x16_bf16(b0, qr[d0], p0, 0, 0, 0);
    p1 = __builtin_amdgcn_mfma_f32_32x32x16_bf16(b1, qr[d0], p1, 0, 0, 0); }
#pragma unroll
  for (int d0 = 0; d0 < 4; ++d0) { const int cb = (d0 * 16 + hi * 8) * 2;
    const bf16x8 b0 = *reinterpret_cast<const bf16x8*>(Kr + KRSWZ(r32, cb));
    const bf16x8 b1 = *reinterpret_cast<const bf16x8*>(Kr + KRSWZ(32 + r32, cb));
    p0 = __builtin_amdgcn_mfma_f32_32x32x16_bf16(b0, qr[8 + d0], p0, 0, 0, 0);
    p1 = __builtin_amdgcn_mfma_f32_32x32x16_bf16(b1, qr[8 + d0], p1, 0, 0, 0); }
  __builtin_amdgcn_s_setprio(0);
}
__device__ __forceinline__ void pv_mla(f32x16* o, int vb, bf16x8 pa0, bf16x8 pa1, bf16x8 pa2, bf16x8 pa3) {
  pv_one<4, 0>(o[0], vb, pa0, pa1, pa2, pa3); pv_one<4, 1>(o[1], vb, pa0, pa1, pa2, pa3); pv_one<4, 2>(o[2], vb, pa0, pa1, pa2, pa3); pv_one<4, 3>(o[3], vb, pa0, pa1, pa2, pa3);
}
template <int SDEPTH>
__device__ __forceinline__ void mla_body(const bf16* __restrict__ Qn, const bf16* __restrict__ Qr, const bf16* __restrict__ Kn, const bf16* __restrict__ Kr, const bf16* __restrict__ Vh,
                                         bf16* __restrict__ Ob, int ldo, int seq, char* lds) {
  int tid_ = mk_tid(); asm volatile("" : "+v"(tid_));
  const int tid = tid_, wid = tid >> 6, lane = tid & 63, r32 = lane & 31, hi = lane >> 5;
  char* V_lds = lds + OFF_V; char* KN_lds = lds + OFF_KN; char* KR_lds = lds + OFF_KR;
  float* ws = (float*)(lds + OFF_WS) + wid * 64; float* li_l = ws; float* al_l = ws + 32;
  float m_reg = -1e30f, l_reg = 0; f32x16 o[4] = {}; bf16x8 qr[8];
  char* qrot = lds + OFF_QR + wid * 4096 + lane * 16;
  { const bf16* Qw = Qn + (long)(wid * 32 + r32) * 1024 + hi * 8;
#pragma unroll
    for (int d0 = 0; d0 < 8; ++d0) qr[d0] = *reinterpret_cast<const bf16x8*>(Qw + d0 * 16);
    const bf16* Qw2 = Qr + (long)(wid * 32 + r32) * 512 + hi * 8;
#pragma unroll
    for (int d0 = 0; d0 < 4; ++d0) *reinterpret_cast<bf16x8*>(qrot + d0 * 1024) = *reinterpret_cast<const bf16x8*>(Qw2 + d0 * 16); }
  const int sr = tid >> 4, sc = (tid & 15) * 8, vst0 = v_st<4>(sr, sc), vst1 = v_st<4>(32 + sr, sc);
  const int rr = tid >> 3, rc = (tid & 7) * 8;
  const int vb0 = (int)(uintptr_t)V_lds + v_rd_base(lane);
  bf16x8 s_vs0, s_vs1, s_ks0, s_ks1, s_kr;
#define SLOAD(k0) do { s_vs0 = *reinterpret_cast<const bf16x8*>(&Vh[(long)((k0) + sr) * 1024 + sc]); s_vs1 = *reinterpret_cast<const bf16x8*>(&Vh[(long)((k0) + 32 + sr) * 1024 + sc]); \
    s_ks0 = *reinterpret_cast<const bf16x8*>(&Kn[(long)((k0) + sr) * 1024 + sc]); s_ks1 = *reinterpret_cast<const bf16x8*>(&Kn[(long)((k0) + 32 + sr) * 1024 + sc]); \
    s_kr = *reinterpret_cast<const bf16x8*>(&Kr[(long)((k0) + rr) * 64 + rc]); } while (0)
#define SWRITE(b) do { *(bf16x8*)(V_lds + (b) * SHM_V + vst0) = s_vs0; *(bf16x8*)(V_lds + (b) * SHM_V + vst1) = s_vs1; const int kc = sc * 2; \
    *(bf16x8*)(KN_lds + (b) * SHM_KN + KNSWZ(sr, kc)) = s_ks0; *(bf16x8*)(KN_lds + (b) * SHM_KN + KNSWZ(32 + sr, kc)) = s_ks1; \
    *(bf16x8*)(KR_lds + (b) * SHM_KR + KRSWZ(rr, rc * 2)) = s_kr; } while (0)
  const int NT = seq / 64;
  SLOAD(0); asm volatile("s_waitcnt vmcnt(0)" ::: "memory"); SWRITE(0); __syncthreads();
#pragma unroll 1
  for (int j = 0; j < NT; ++j) {
    const int b = j & 1;
    if (j + 1 < NT) SLOAD((j + 1) * 64);
    SBAR();
    f32x16 p0, p1; float mn, alpha; bf16x8 pa0, pa1, pa2, pa3;
    qkt_mla(p0, p1, KN_lds + b * SHM_KN, KR_lds + b * SHM_KR, qr, qrot, r32, hi);
    partialSM(p0, p1, m_reg, mn, alpha);
    if (__any(alpha < 1.f)) { if (hi == 0) al_l[r32] = alpha; asm volatile("s_waitcnt lgkmcnt(0)" ::: "memory");
#pragma unroll
      for (int d = 0; d < 4; ++d)
#pragma unroll
        for (int r = 0; r < 16; ++r) o[d][r] *= al_l[crow(r, hi)]; }
    finishSM(p0, p1, alpha, l_reg, pa0, pa1, pa2, pa3); SBAR();
    pv_mla(o, vb0 + b * SHM_V, pa0, pa1, pa2, pa3);
    if (j + 1 < NT) { asm volatile("s_waitcnt vmcnt(0)" ::: "memory"); SWRITE(b ^ 1); }
    __syncthreads();
  }
  if (hi == 0) li_l[r32] = l_reg; asm volatile("s_waitcnt lgkmcnt(0)" ::: "memory");
  float rli[16];
#pragma unroll
  for (int r = 0; r < 16; ++r) rli[r] = __builtin_amdgcn_rcpf(li_l[crow(r, hi)]);
  bf16* Ow = Ob + (long)(wid * 32) * ldo;
#pragma unroll
  for (int r = 0; r < 16; ++r) { const int orow = crow(r, hi);
#pragma unroll
    for (int d0 = 0; d0 < 4; ++d0) Ow[(long)orow * ldo + d0 * 32 + r32] = (bf16)(cvtpk(o[d0][r] * rli[r], 0.f) & 0xffffu); }
  __syncthreads();
#undef SLOAD
#undef SWRITE
}
constexpr float THRZ = 64.f;
__device__ __forceinline__ void partialSM_z(f32x16& p0, f32x16& p1, float& m_reg, bool& shifted, float& alpha) {
  float pmax = p0[0];
#pragma unroll
  for (int r = 1; r < 16; ++r) pmax = fmaxf(pmax, p0[r]);
#pragma unroll
  for (int r = 0; r < 16; ++r) pmax = fmaxf(pmax, p1[r]);
  { auto rr = __builtin_amdgcn_permlane32_swap(__float_as_uint(pmax), __float_as_uint(pmax), false, false);
    pmax = fmaxf(__uint_as_float(rr[0]), __uint_as_float(rr[1])); }
  if (__builtin_expect(__all(pmax - m_reg <= THRZ), 1)) { alpha = 1.f; }
  else { const float mn = fmaxf(m_reg, pmax); alpha = __builtin_amdgcn_exp2f(m_reg - mn); m_reg = mn; shifted = true; }
  if (__builtin_expect(shifted, 0)) {
#pragma unroll
    for (int r = 0; r < 16; ++r) { p0[r] -= m_reg; p1[r] -= m_reg; } }
#pragma unroll
  for (int r = 0; r < 16; ++r) p0[r] = __builtin_amdgcn_exp2f(p0[r]);
}
__device__ __forceinline__ void partialSM_m(f32x16& p0, f32x16& p1, float& m_reg, float& alpha, bool first) {
  float pmax = p0[0];
#pragma unroll
  for (int r = 1; r < 16; ++r) pmax = fmaxf(pmax, p0[r]);
#pragma unroll
  for (int r = 0; r < 16; ++r) pmax = fmaxf(pmax, p1[r]);
  { auto rr = __builtin_amdgcn_permlane32_swap(__float_as_uint(pmax), __float_as_uint(pmax), false, false);
    pmax = fmaxf(__uint_as_float(rr[0]), __uint_as_float(rr[1])); }
  alpha = 1.f;
  if (first) m_reg = pmax;
  else if (!__all(pmax - m_reg <= THRZ)) { const float d = fmaxf(pmax - m_reg, 0.f); alpha = __builtin_amdgcn_exp2f(-d); m_reg += d; }
#pragma unroll
  for (int r = 0; r < 16; ++r) { p0[r] -= m_reg; p1[r] -= m_reg; }
#pragma unroll
  for (int r = 0; r < 16; ++r) p0[r] = __builtin_amdgcn_exp2f(p0[r]);
}
template <int OFF> __device__ __forceinline__ bf16x8 kread(int addr) { bf16x8 r; asm volatile("ds_read_b128 %0, %1 offset:%2" : "=&v"(r) : "v"(addr), "i"(OFF) : "memory"); return r; }
#define LGKM(N) asm volatile("s_waitcnt lgkmcnt(" #N ")" ::: "memory")
#define LGKMV(N, X) asm volatile("s_waitcnt lgkmcnt(" #N ")" : "+v"(X) :: "memory")
#define LGKMV4(N, A, B, C, D) asm volatile("s_waitcnt lgkmcnt(" #N ")" : "+v"(A), "+v"(B), "+v"(C), "+v"(D) :: "memory")
#define LGKMV2(N, A, B) asm volatile("s_waitcnt lgkmcnt(" #N ")" : "+v"(A), "+v"(B) :: "memory")
#define LGKMV5(N, A, B, C, D, E) asm volatile("s_waitcnt lgkmcnt(" #N ")" : "+v"(A), "+v"(B), "+v"(C), "+v"(D), "+v"(E) :: "memory")
#define PIN1(A) asm volatile("" : "+v"(A))
#define PIN2(A, B) asm volatile("" : "+v"(A), "+v"(B))
#define PIN3(A, B, C) asm volatile("" : "+v"(A), "+v"(B), "+v"(C))
#define PIN4(A, B, C, D) asm volatile("" : "+v"(A), "+v"(B), "+v"(C), "+v"(D))
template <int K> __device__ __forceinline__ void k_rd(bf16x8& a, bf16x8& b, int blN, int blR) {
  if constexpr (K < 8) { const int ad = blN ^ (K << 5); a = kread<0>(ad); b = kread<8192>(ad); }
  else { const int ad = blR ^ ((K - 8) << 5); a = kread<0>(ad); b = kread<4096>(ad); }
}
template <int C, int VAR> __device__ __forceinline__ void fin_chunk(f32x16& p0, f32x16& p1, float alpha, float& l_reg, float& ps0, float& ps1, unsigned (&t)[4], bf16x8& pa0, bf16x8& pa1, bf16x8& pa2, bf16x8& pa3) {
  if constexpr (C < 8) { if constexpr (VAR & 8) { p1[2 * C] *= 1.0001f; p1[2 * C + 1] *= 1.0001f; } else { p1[2 * C] = __builtin_amdgcn_exp2f(p1[2 * C]); p1[2 * C + 1] = __builtin_amdgcn_exp2f(p1[2 * C + 1]); }
    if constexpr (C == 0) ps0 = p0[0] + p0[1]; else { ps0 += p0[2 * C]; ps0 += p0[2 * C + 1]; }
    PIN3(p1[2 * C], p1[2 * C + 1], ps0); }
  else if constexpr (C < 16) { constexpr int I = C - 8;
    if constexpr (I == 0) ps1 = p1[0] + p1[1]; else { ps1 += p1[2 * I]; ps1 += p1[2 * I + 1]; }
    if constexpr (I == 0) { t[0] = cvtpk(p0[0], p0[1]); t[1] = cvtpk(p0[2], p0[3]); }
    else if constexpr (I == 1) { t[2] = cvtpk(p0[4], p0[5]); t[3] = cvtpk(p0[6], p0[7]); }
    else if constexpr (I == 2) { auto r0 = __builtin_amdgcn_permlane32_swap(t[0], t[2], false, false); auto r1 = __builtin_amdgcn_permlane32_swap(t[1], t[3], false, false); u32x4 w = {r0[0], r1[0], r0[1], r1[1]}; PIN4(w.x, w.y, w.z, w.w); pa0 = __builtin_bit_cast(bf16x8, w); }
    else if constexpr (I == 3) { t[0] = cvtpk(p0[8], p0[9]); t[1] = cvtpk(p0[10], p0[11]); }
    else if constexpr (I == 4) { t[2] = cvtpk(p0[12], p0[13]); t[3] = cvtpk(p0[14], p0[15]); }
    else if constexpr (I == 5) { auto r0 = __builtin_amdgcn_permlane32_swap(t[0], t[2], false, false); auto r1 = __builtin_amdgcn_permlane32_swap(t[1], t[3], false, false); u32x4 w = {r0[0], r1[0], r0[1], r1[1]}; PIN4(w.x, w.y, w.z, w.w); pa1 = __builtin_bit_cast(bf16x8, w); }
    PIN1(ps1); }
  else if constexpr (C == 16) { float ps = ps0 + ps1; auto rr = __builtin_amdgcn_permlane32_swap(__float_as_uint(ps), __float_as_uint(ps), false, false); ps = __uint_as_float(rr[0]) + __uint_as_float(rr[1]); l_reg = l_reg * alpha + ps; PIN1(l_reg); }
  else if constexpr (C == 17) { t[0] = cvtpk(p1[0], p1[1]); t[1] = cvtpk(p1[2], p1[3]); }
  else if constexpr (C == 18) { t[2] = cvtpk(p1[4], p1[5]); t[3] = cvtpk(p1[6], p1[7]); }
  else if constexpr (C == 19) { auto r0 = __builtin_amdgcn_permlane32_swap(t[0], t[2], false, false); auto r1 = __builtin_amdgcn_permlane32_swap(t[1], t[3], false, false); u32x4 w = {r0[0], r1[0], r0[1], r1[1]}; PIN4(w.x, w.y, w.z, w.w); pa2 = __builtin_bit_cast(bf16x8, w); }
  else if constexpr (C == 20) { t[0] = cvtpk(p1[8], p1[9]); t[1] = cvtpk(p1[10], p1[11]); }
  else if constexpr (C == 21) { t[2] = cvtpk(p1[12], p1[13]); t[3] = cvtpk(p1[14], p1[15]); }
  else if constexpr (C == 22) { auto r0 = __builtin_amdgcn_permlane32_swap(t[0], t[2], false, false); auto r1 = __builtin_amdgcn_permlane32_swap(t[1], t[3], false, false); u32x4 w = {r0[0], r1[0], r0[1], r1[1]}; PIN4(w.x, w.y, w.z, w.w); pa3 = __builtin_bit_cast(bf16x8, w); }
}
template <int I> __device__ __forceinline__ bf16x8 kf_rd(int blN, int blR) {
  if constexpr (I < 16) return (I & 1) ? kread<8192>(blN ^ ((I >> 1) << 5)) : kread<0>(blN ^ ((I >> 1) << 5));
  else return (I & 1) ? kread<4096>(blR ^ (((I >> 1) - 8) << 5)) : kread<0>(blR ^ (((I >> 1) - 8) << 5));
}
template <int VAR, typename DmaF>
__device__ __forceinline__ void step_qk_fin(f32x16& c0, f32x16& c1, const f32x16& NM, f32x16& p0, f32x16& p1, float alpha, float& l_reg, bf16x8& pa0, bf16x8& pa1, bf16x8& pa2, bf16x8& pa3,
                                            const bf16x8* qr, int qrot_ad, int blN, int blR, DmaF dma) {
  bf16x8 f[24], qt[4]; float ps0 = 0.f, ps1 = 0.f; unsigned t[4] = {0u, 0u, 0u, 0u};
  SBAR(); f[0] = kf_rd<0>(blN, blR); f[1] = kf_rd<1>(blN, blR);
#define QB(I) ((I) < 16 ? qr[((I) >> 1) & 7] : qt[(((I) >> 1) - 8) & 3])
#define QK_ONE(I, WAITN) do { if constexpr ((I) == 14) { qt[0] = kread<0>(qrot_ad); qt[1] = kread<1024>(qrot_ad); qt[2] = kread<2048>(qrot_ad); qt[3] = kread<3072>(qrot_ad); } \
    if constexpr ((I) + 2 < 24) f[((I) + 2) % 24] = kf_rd<((I) + 2 < 24 ? (I) + 2 : 0)>(blN, blR); \
    if constexpr (!(VAR & 4)) { if constexpr ((I) == 16) LGKMV5(WAITN, f[I], qt[0], qt[1], qt[2], qt[3]); else LGKMV(WAITN, f[I]); } SBAR(); \
    if constexpr ((I) == 0) c0 = __builtin_amdgcn_mfma_f32_32x32x16_bf16(f[I], QB(I), NM, 0, 0, 0); \
    else if constexpr ((I) == 1) c1 = __builtin_amdgcn_mfma_f32_32x32x16_bf16(f[I], QB(I), NM, 0, 0, 0); \
    else if constexpr (((I) & 1) == 0) c0 = __builtin_amdgcn_mfma_f32_32x32x16_bf16(f[I], QB(I), c0, 0, 0, 0); else c1 = __builtin_amdgcn_mfma_f32_32x32x16_bf16(f[I], QB(I), c1, 0, 0, 0); \
    if constexpr (!(VAR & 1)) fin_chunk<(I), VAR>(p0, p1, alpha, l_reg, ps0, ps1, t, pa0, pa1, pa2, pa3); SBAR(); } while (0)
  QK_ONE(0, 2); QK_ONE(1, 2); QK_ONE(2, 2); QK_ONE(3, 2); QK_ONE(4, 2); QK_ONE(5, 2); QK_ONE(6, 2); QK_ONE(7, 2); QK_ONE(8, 2); QK_ONE(9, 2); QK_ONE(10, 2); QK_ONE(11, 2);
  dma(); SBAR();
  QK_ONE(12, 2); QK_ONE(13, 2); QK_ONE(14, 6); QK_ONE(15, 6); QK_ONE(16, 2); QK_ONE(17, 2); QK_ONE(18, 2); QK_ONE(19, 2); QK_ONE(20, 2); QK_ONE(21, 2); QK_ONE(22, 1); QK_ONE(23, 0);
#undef QK_ONE
#undef QB
}
template <int VAR>
__device__ __forceinline__ void step_pv_max(f32x16* o, int vb, bf16x8 pa0, bf16x8 pa1, bf16x8 pa2, bf16x8 pa3, f32x16& c0, f32x16& c1, float& m_reg, float& alpha, f32x16& NM) {
  s16x4 fl[4][4], fh[4][4]; float pm = 0.f; alpha = 1.f;
#define PK(L, H) (bf16x8){L[0], L[1], L[2], L[3], H[0], H[1], H[2], H[3]}
#define RDF(KS, D) do { fl[KS][D] = tr_read<v_rd_off<4>(D, KS, 0)>(vb); fh[KS][D] = tr_read<v_rd_off<4>(D, KS, 1)>(vb); } while (0)
#define MX3(A, B) pm = fmaxf(fmaxf(pm, A), B)
#define PV_CHUNK(C) do { if constexpr (VAR & 2) break; \
    if constexpr ((C) == 0) { pm = fmaxf(fmaxf(c0[0], c0[1]), c0[2]); MX3(c0[3], c0[4]); MX3(c0[5], c0[6]); PIN1(pm); } \
    else if constexpr ((C) == 1) { MX3(c0[7], c0[8]); MX3(c0[9], c0[10]); MX3(c0[11], c0[12]); PIN1(pm); } \
    else if constexpr ((C) == 2) { MX3(c0[13], c0[14]); MX3(c0[15], c1[0]); MX3(c1[1], c1[2]); PIN1(pm); } \
    else if constexpr ((C) == 3) { MX3(c1[3], c1[4]); MX3(c1[5], c1[6]); MX3(c1[7], c1[8]); PIN1(pm); } \
    else if constexpr ((C) == 4) { MX3(c1[9], c1[10]); MX3(c1[11], c1[12]); MX3(c1[13], c1[14]); PIN1(pm); } \
    else if constexpr ((C) == 5) { pm = fmaxf(pm, c1[15]); auto rr = __builtin_amdgcn_permlane32_swap(__float_as_uint(pm), __float_as_uint(pm), false, false); pm = fmaxf(__uint_as_float(rr[0]), __uint_as_float(rr[1])); PIN1(pm); } \
    else if constexpr ((C) >= 8 && (VAR & 8)) { c0[2 * ((C) - 8)] *= 1.0001f; c0[2 * ((C) - 8) + 1] *= 1.0001f; PIN2(c0[2 * ((C) - 8)], c0[2 * ((C) - 8) + 1]); } \
    else if constexpr ((C) >= 8) { c0[2 * ((C) - 8)] = __builtin_amdgcn_exp2f(c0[2 * ((C) - 8)]); c0[2 * ((C) - 8) + 1] = __builtin_amdgcn_exp2f(c0[2 * ((C) - 8) + 1]); PIN2(c0[2 * ((C) - 8)], c0[2 * ((C) - 8) + 1]); } } while (0)
#define PV_FIX() do { if (__builtin_expect(!__all(pm <= THRZ), 0)) { const float d = fmaxf(pm, 0.f); alpha = __builtin_amdgcn_exp2f(-d); m_reg += d; const float nm = -m_reg; \
      _Pragma("unroll") for (int r = 0; r < 16; ++r) { c0[r] -= d; c1[r] -= d; NM[r] = nm; } } SBAR(); } while (0)
#define PV_ONE(KS, D, PA, WN) do { if constexpr ((KS) < 3) RDF(((KS) < 3 ? (KS) + 1 : 0), D); if constexpr (!(VAR & 4)) LGKMV2(WN, fl[KS][D], fh[KS][D]); SBAR(); \
    o[D] = __builtin_amdgcn_mfma_f32_32x32x16_bf16(PA, PK(fl[KS][D], fh[KS][D]), o[D], 0, 0, 0); PV_CHUNK(4 * (KS) + (D)); SBAR(); } while (0)
  SBAR(); RDF(0, 0); RDF(0, 1); RDF(0, 2); RDF(0, 3);
  PV_ONE(0, 0, pa0, 8); PV_ONE(0, 1, pa0, 8); PV_ONE(0, 2, pa0, 8); PV_ONE(0, 3, pa0, 8);
  PV_ONE(1, 0, pa1, 8); PV_ONE(1, 1, pa1, 8); PV_ONE(1, 2, pa1, 8); PV_ONE(1, 3, pa1, 8);
  PV_FIX();
  PV_ONE(2, 0, pa2, 8); PV_ONE(2, 1, pa2, 8); PV_ONE(2, 2, pa2, 8); PV_ONE(2, 3, pa2, 8);
  PV_ONE(3, 0, pa3, 6); PV_ONE(3, 1, pa3, 4); PV_ONE(3, 2, pa3, 2); PV_ONE(3, 3, pa3, 0);
#undef PV_ONE
#undef PV_FIX
#undef PV_CHUNK
#undef MX3
#undef RDF
#undef PK
}
constexpr int R3_V = 0, R3_KN = 3 * SHM_V, R3_KR = R3_KN + 3 * SHM_KN, R3_WS = R3_KR + 3 * SHM_KR, R3_QR = R3_WS + NWAVES * 256, MLA3_LDS = R3_QR + NWAVES * 4096;
template <int VAR>
__device__ __forceinline__ void mla_body2(const bf16* __restrict__ Qn, const bf16* __restrict__ Qr, const bf16* __restrict__ Kn, const bf16* __restrict__ Kr, const bf16* __restrict__ Vh,
                                          bf16* __restrict__ Ob, int ldo, int seq, char* lds, LAS unsigned char* ldsl) {
  int tid_ = mk_tid(); asm volatile("" : "+v"(tid_));
  const int tid = tid_, wid = __builtin_amdgcn_readfirstlane(tid >> 6), lane = tid & 63, r32 = lane & 31, hi = lane >> 5;
  char* V_lds = lds + R3_V; char* KN_lds = lds + R3_KN; char* KR_lds = lds + R3_KR;
  float* ws = (float*)(lds + R3_WS) + wid * 64; float* li_l = ws; float* al_l = ws + 32;
  float m_reg = 0.f, l_reg = 0; f32x16 o[4] = {}; bf16x8 qr[8];
  char* qrot = lds + R3_QR + wid * 4096 + lane * 16;
  { const bf16* Qw = Qn + (long)(wid * 32 + r32) * 1024 + hi * 8;
#pragma unroll
    for (int d0 = 0; d0 < 8; ++d0) qr[d0] = *reinterpret_cast<const bf16x8*>(Qw + d0 * 16);
    const bf16* Qw2 = Qr + (long)(wid * 32 + r32) * 512 + hi * 8;
#pragma unroll
    for (int d0 = 0; d0 < 4; ++d0) *reinterpret_cast<bf16x8*>(qrot + d0 * 1024) = *reinterpret_cast<const bf16x8*>(Qw2 + d0 * 16); }
  unsigned offKN[1], offV[1], offKR;
#pragma unroll
  for (int i = 0; i < 1; ++i) { const int ch = wid + 8 * i;
    { const int row = ch * 4 + (lane >> 4), colB = ((lane & 15) << 4) ^ ((row & 15) << 4); offKN[i] = (unsigned)(row * 2048 + colB); }
    { const int sidx = ch * 2 + (lane >> 5), kk = (sidx >> 2) * 8 + ((lane & 31) >> 2), k = (kk & ~0xC) | ((kk & 4) << 1) | ((kk & 8) >> 1), c = (sidx & 3) * 32 + (lane & 3) * 8; offV[i] = (unsigned)(k * 2048 + c * 2); } }
  { const int row = wid * 8 + (lane >> 3), colB = ((lane & 7) << 4) ^ (((row >> 1) & 7) << 4); offKR = (unsigned)(row * 128 + colB); }
  const int vb0 = (int)(uintptr_t)V_lds + v_rd_base(lane);
#define DMA(slot, k0) do { const char* kn_ = (const char*)(Kn + (size_t)(k0) * 1024); const char* kr_ = (const char*)(Kr + (size_t)(k0) * 64); const char* vh_ = (const char*)(Vh + (size_t)(k0) * 1024); \
    __builtin_amdgcn_global_load_lds((const unsigned*)(kn_ + offKN[0]), (LAS unsigned*)(ldsl + R3_KN + (slot) * SHM_KN + wid * 1024), 16, 0, 0); \
    __builtin_amdgcn_global_load_lds((const unsigned*)(kn_ + 65536 + offKN[0]), (LAS unsigned*)(ldsl + R3_KN + (slot) * SHM_KN + 8192 + wid * 1024), 16, 0, 0); \
    __builtin_amdgcn_global_load_lds((const unsigned*)(kr_ + offKR), (LAS unsigned*)(ldsl + R3_KR + (slot) * SHM_KR + wid * 1024), 16, 0, 0); \
    __builtin_amdgcn_global_load_lds((const unsigned*)(vh_ + offV[0]), (LAS unsigned*)(ldsl + R3_V + (slot) * SHM_V + wid * 1024), 16, 0, 0); \
    __builtin_amdgcn_global_load_lds((const unsigned*)(vh_ + 65536 + offV[0]), (LAS unsigned*)(ldsl + R3_V + (slot) * SHM_V + 8192 + wid * 1024), 16, 0, 0); } while (0)
#define STEPBAR() asm volatile("s_waitcnt vmcnt(0) lgkmcnt(0)\n\ts_barrier" ::: "memory")
#define RESC(a) do { if (__any((a) < 1.f)) { if (hi == 0) al_l[r32] = (a); asm volatile("s_waitcnt lgkmcnt(0)" ::: "memory"); \
    _Pragma("unroll") for (int d = 0; d < 4; ++d) _Pragma("unroll") for (int r = 0; r < 16; ++r) o[d][r] *= al_l[crow(r, hi)]; } } while (0)
  f32x16 pA0, pA1, pB0, pB1; float mnA, mnB, alA, alB; bf16x8 pa0, pa1, pa2, pa3; const int NT = seq / 64;
  DMA(0, 0); DMA(1, 64); STEPBAR();
  qkt_mla(pA0, pA1, KN_lds, KR_lds, qr, qrot, r32, hi); partialSM_m(pA0, pA1, m_reg, alA, true);
  f32x16 NM; { const float nm = -m_reg;
#pragma unroll
    for (int r = 0; r < 16; ++r) NM[r] = nm; }
  asm volatile("" : "+v"(NM));
  int sp = 0, sj = 1, sn = 2;
  const int qrot_ad = (int)(uintptr_t)qrot;
  const int blN0 = (int)(uintptr_t)KN_lds + r32 * 256 + ((hi ^ (r32 & 15)) << 4), blR0 = (int)(uintptr_t)KR_lds + r32 * 128 + ((hi ^ ((r32 >> 1) & 7)) << 4);
#define MLA_STEP(C0, C1, ALC, P0, P1, ALP, DMACOND, K0) do { \
    step_qk_fin<VAR>(C0, C1, NM, P0, P1, ALP, l_reg, pa0, pa1, pa2, pa3, qr, qrot_ad, blN0 + sj * SHM_KN, blR0 + sj * SHM_KR, [&]() { if (DMACOND) DMA(sn, K0); }); \
    step_pv_max<VAR>(o, vb0 + sp * SHM_V, pa0, pa1, pa2, pa3, C0, C1, m_reg, ALC, NM); \
    RESC(ALC); STEPBAR(); { const int t_ = sp; sp = sj; sj = sn; sn = t_; } } while (0)
  if (wid >= 4) __builtin_amdgcn_s_setprio(1);
#pragma unroll 1
  for (int j = 1; j + 1 < NT; j += 2) {
    MLA_STEP(pB0, pB1, alB, pA0, pA1, alA, true, (j + 1) * 64);
    MLA_STEP(pA0, pA1, alA, pB0, pB1, alB, j + 2 < NT, (j + 2) * 64);
  }
#undef MLA_STEP
  __builtin_amdgcn_s_setprio(0);
  int r32t = r32, hit = hi; asm volatile("" : "+v"(r32t), "+v"(hit));
  SBAR(); qkt_mla(pB0, pB1, KN_lds + sj * SHM_KN, KR_lds + sj * SHM_KR, qr, qrot, r32t, hit);
  finishSM(pA0, pA1, alA, l_reg, pa0, pa1, pa2, pa3); SBAR();
  pv_mla(o, vb0 + sp * SHM_V, pa0, pa1, pa2, pa3); partialSM_m(pB0, pB1, m_reg, alB, false);
  RESC(alB);
  finishSM(pB0, pB1, alB, l_reg, pa0, pa1, pa2, pa3); SBAR();
  pv_mla(o, vb0 + sj * SHM_V, pa0, pa1, pa2, pa3);
  if (hit == 0) li_l[r32t] = l_reg; asm volatile("s_waitcnt lgkmcnt(0)" ::: "memory");
  float rli[16];
#pragma unroll
  for (int r = 0; r < 16; ++r) rli[r] = __builtin_amdgcn_rcpf(li_l[crow(r, hit)]);
  bf16* Ow = Ob + (long)(wid * 32) * ldo;
#pragma unroll
  for (int r = 0; r < 16; ++r) { const int orow = crow(r, hit);
#pragma unroll
    for (int d0 = 0; d0 < 4; ++d0) Ow[(long)orow * ldo + d0 * 32 + r32t] = (bf16)(cvtpk(o[d0][r] * rli[r], 0.f) & 0xffffu); }
  __syncthreads();
#undef DMA
#undef STEPBAR
#undef RESC
}
}
namespace natt {
using att::bf16x8; using att::f32x16; using att::crow; using att::cvtpk;
constexpr int NA_V_BYTES = 8192, NA_K_BYTES = 8192;
constexpr int NA_OFF_RPB = NWAVES * (NA_V_BYTES + NA_K_BYTES);
constexpr int NA_OFF_WS = NA_OFF_RPB + 14912;
constexpr float LOG2E = 1.4426950408889634f;
#define NA_KSWZ(row, colB) ((row) * 128 + ((colB) ^ ((((row) >> 1) & 7) << 4)))
__device__ __forceinline__ void na_unit(const bf16* __restrict__ QKV, bf16* __restrict__ Y, const float* rpbS, char* lds, int unit, int wid, int lane) {
  const int qb = unit & 1, h = (unit >> 1) & 7, r = (unit >> 4) & 255, b = unit >> 12, r32 = lane & 31, hi = lane >> 5;
  int rs = r - 4; rs = rs < 0 ? 0 : (rs > 248 ? 248 : rs);
  char* Vw = lds + wid * (NA_V_BYTES + NA_K_BYTES); char* Kw = Vw + NA_V_BYTES; float* al_l = (float*)(lds + NA_OFF_WS) + wid * 64; float* li_l = al_l + 32;
  const int vb = (int)(uintptr_t)Vw + att::v_rd_base(lane);
  const long tok0 = (long)b * SEQ + (long)r * 64;
  bf16x8 qf[4];
#pragma unroll
  for (int d0 = 0; d0 < 4; ++d0) qf[d0] = *reinterpret_cast<const bf16x8*>(QKV + (tok0 + qb * 32 + r32) * 1536 + h * 64 + d0 * 16 + hi * 8);
  float m_reg = -1e30f, l_reg = 0.f; f32x16 o[2] = {};
  const int c = qb * 32 + r32; int cs = c - 8; cs = cs < 0 ? 0 : (cs > 48 ? 48 : cs);
  const int lk = lane >> 3, lc = lane & 7;
  bf16x8 kv[8], vv[8];
#define NA_LOAD(R_) do { const bf16* base_ = QKV + ((long)b * SEQ + (long)(R_) * 64 + lk) * 1536 + h * 64 + lc * 8; \
    _Pragma("unroll") for (int i = 0; i < 8; ++i) { kv[i] = *reinterpret_cast<const bf16x8*>(base_ + (long)(8 * i) * 1536 + 512); vv[i] = *reinterpret_cast<const bf16x8*>(base_ + (long)(8 * i) * 1536 + 1024); } } while (0)
  NA_LOAD(rs);
#pragma unroll 1
  for (int kr = 0; kr < 8; ++kr) { const int R = rs + kr;
#pragma unroll
    for (int i = 0; i < 8; ++i) { *(bf16x8*)(Kw + NA_KSWZ(lk + 8 * i, lc * 16)) = kv[i]; *(bf16x8*)(Vw + att::v_st<2>(lk + 8 * i, lc * 8)) = vv[i]; }
    asm volatile("s_waitcnt lgkmcnt(0)" ::: "memory");
    if (kr < 7) NA_LOAD(R + 1);
    const float* brow = rpbS + (h * 15 + (R - r + 7)) * 31;
    f32x16 p0 = {}, p1 = {};
#pragma unroll
    for (int d0 = 0; d0 < 4; ++d0) { const int cb = (d0 * 16 + hi * 8) * 2;
      const bf16x8 k0 = *reinterpret_cast<const bf16x8*>(Kw + NA_KSWZ(r32, cb)), k1 = *reinterpret_cast<const bf16x8*>(Kw + NA_KSWZ(32 + r32, cb));
      p0 = __builtin_amdgcn_mfma_f32_32x32x16_bf16(k0, qf[d0], p0, 0, 0, 0); p1 = __builtin_amdgcn_mfma_f32_32x32x16_bf16(k1, qf[d0], p1, 0, 0, 0); }
    float pmax = -1e30f;
#pragma unroll
    for (int rg = 0; rg < 16; ++rg) { const int j0 = crow(rg, hi), j1 = 32 + j0;
      const bool v0 = (j0 >= cs) && (j0 < cs + 16), v1 = (j1 >= cs) && (j1 < cs + 16);
      const float b0 = v0 ? brow[j0 - c + 15] : 0.f, b1 = v1 ? brow[j1 - c + 15] : 0.f;
      p0[rg] = v0 ? (p0[rg] * 0.125f + b0) * LOG2E : -1e30f; p1[rg] = v1 ? (p1[rg] * 0.125f + b1) * LOG2E : -1e30f;
      pmax = fmaxf(pmax, fmaxf(p0[rg], p1[rg])); }
    { auto rr = __builtin_amdgcn_permlane32_swap(__float_as_uint(pmax), __float_as_uint(pmax), false, false); pmax = fmaxf(__uint_as_float(rr[0]), __uint_as_float(rr[1])); }
    const float mn = fmaxf(m_reg, pmax), alpha = __builtin_amdgcn_exp2f(m_reg - mn); m_reg = mn;
    float ps = 0.f;
#pragma unroll
    for (int rg = 0; rg < 16; ++rg) { p0[rg] = __builtin_amdgcn_exp2f(p0[rg] - mn); p1[rg] = __builtin_amdgcn_exp2f(p1[rg] - mn); ps += p0[rg] + p1[rg]; }
    { auto rr = __builtin_amdgcn_permlane32_swap(__float_as_uint(ps), __float_as_uint(ps), false, false); ps = __uint_as_float(rr[0]) + __uint_as_float(rr[1]); }
    l_reg = l_reg * alpha + ps;
    bf16x8 pa0, pa1, pa2, pa3;
#define PK4(P, BASE, OUT) do { unsigned a0 = cvtpk(P[BASE + 0], P[BASE + 1]), a1 = cvtpk(P[BASE + 2], P[BASE + 3]);   \
    unsigned b0_ = cvtpk(P[BASE + 4], P[BASE + 5]), b1_ = cvtpk(P[BASE + 6], P[BASE + 7]);                              \
    auto r0 = __builtin_amdgcn_permlane32_swap(a0, b0_, false, false); auto r1 = __builtin_amdgcn_permlane32_swap(a1, b1_, false, false); \
    u32x4 w = {r0[0], r1[0], r0[1], r1[1]}; OUT = *reinterpret_cast<bf16x8*>(&w); } while (0)
    PK4(p0, 0, pa0); PK4(p0, 8, pa1); PK4(p1, 0, pa2); PK4(p1, 8, pa3);
#undef PK4
    if (hi == 0) al_l[r32] = alpha;
    asm volatile("s_waitcnt lgkmcnt(0)" ::: "memory");
#pragma unroll
    for (int d = 0; d < 2; ++d)
#pragma unroll
      for (int rg = 0; rg < 16; ++rg) o[d][rg] *= al_l[crow(rg, hi)];
    asm volatile("s_waitcnt lgkmcnt(0)" ::: "memory");
    att::pv_one<2, 0>(o[0], vb, pa0, pa1, pa2, pa3); att::pv_one<2, 1>(o[1], vb, pa0, pa1, pa2, pa3);
    asm volatile("s_waitcnt lgkmcnt(0)" ::: "memory");
  }
#undef NA_LOAD
  if (hi == 0) li_l[r32] = l_reg;
  asm volatile("s_waitcnt lgkmcnt(0)" ::: "memory");
  bf16* Ow = Y + (tok0 + qb * 32) * 1536 + h * 64;
#pragma unroll
  for (int rg = 0; rg < 16; ++rg) { const int orow = crow(rg, hi); const float rl = __builtin_amdgcn_rcpf(li_l[orow]);
#pragma unroll
    for (int d = 0; d < 2; ++d) Ow[(long)orow * 1536 + d * 32 + r32] = (bf16)(cvtpk(o[d][rg] * rl, 0.f) & 0xffffu); }
  asm volatile("s_waitcnt lgkmcnt(0)" ::: "memory");
}
#undef NA_KSWZ
}
namespace hfft {
constexpr int M = 16384;
__device__ __forceinline__ int pad(int i) { return i + (i >> 4); }
__device__ __forceinline__ f32x2 cadd(f32x2 a, f32x2 b) { return (f32x2){fadd_s(a.x, b.x), fadd_s(a.y, b.y)}; }
__device__ __forceinline__ f32x2 csub(f32x2 a, f32x2 b) { return (f32x2){fsub_s(a.x, b.x), fsub_s(a.y, b.y)}; }
__device__ __forceinline__ f32x2 cmul(f32x2 a, f32x2 b) { const float t0 = fmul_s(a.y, b.y), t1 = fmul_s(a.y, b.x); return (f32x2){ffnma_s(a.x, b.x, t0), ffma_s(a.x, b.y, t1)}; }
template <unsigned CXB, unsigned CYB, unsigned NCYB> __device__ __forceinline__ f32x2 cmul_lit(f32x2 a) {
  float re, im;
  asm("v_mul_f32_e32 %0, %1, %2" : "=v"(re) : "n"(CXB), "v"(a.x)); asm("v_fmac_f32_e32 %0, %1, %2" : "+v"(re) : "n"(NCYB), "v"(a.y));
  asm("v_mul_f32_e32 %0, %1, %2" : "=v"(im) : "n"(CYB), "v"(a.x)); asm("v_fmac_f32_e32 %0, %1, %2" : "+v"(im) : "n"(CXB), "v"(a.y));
  return (f32x2){re, im};
}
constexpr unsigned fbits(float f) { return __builtin_bit_cast(unsigned, f); }
__device__ constexpr float C32(int k) { return k == 0 ? 1.000000000e+00f : k == 1 ? 9.807852804e-01f : k == 2 ? 9.238795325e-01f : k == 3 ? 8.314696123e-01f : k == 4 ? 7.071067812e-01f : k == 5 ? 5.555702330e-01f : k == 6 ? 3.826834324e-01f : k == 7 ? 1.950903220e-01f : k == 8 ? 0.000000000e+00f : k == 9 ? -1.950903220e-01f : k == 10 ? -3.826834324e-01f : k == 11 ? -5.555702330e-01f : k == 12 ? -7.071067812e-01f : k == 13 ? -8.314696123e-01f : k == 14 ? -9.238795325e-01f : -9.807852804e-01f; }
__device__ constexpr float S32(int k) { return k == 0 ? 0.000000000e+00f : k == 1 ? 1.950903220e-01f : k == 2 ? 3.826834324e-01f : k == 3 ? 5.555702330e-01f : k == 4 ? 7.071067812e-01f : k == 5 ? 8.314696123e-01f : k == 6 ? 9.238795325e-01f : k == 7 ? 9.807852804e-01f : k == 8 ? 1.000000000e+00f : k == 9 ? 9.807852804e-01f : k == 10 ? 9.238795325e-01f : k == 11 ? 8.314696123e-01f : k == 12 ? 7.071067812e-01f : k == 13 ? 5.555702330e-01f : k == 14 ? 3.826834324e-01f : 1.950903220e-01f; }
template <int HL, int J> constexpr int el_off() { constexpr int HMIN = 1 << HL; return HL >= 4 ? J * (HMIN + (HMIN >> 4)) : HL == 2 ? 4 * J + (J >> 2) : J; }
template <int R, bool INV, int Q, int J> __device__ __forceinline__ void fft_bfly(f32x2 (&v)[1 << R], const f32x2 (&w)[R]) {
  constexpr int span = 1 << (R - 1 - Q);
  if constexpr ((J & span) == 0) { constexpr int jj = J & (span - 1), ci = jj * (16 / span);
    if constexpr (!INV) { f32x2 tw; if constexpr (ci == 0) tw = w[Q]; else tw = (f32x2){w[Q].x * C32(ci) + w[Q].y * S32(ci), w[Q].y * C32(ci) - w[Q].x * S32(ci)}; const f32x2 a = v[J], bq = v[J + span]; v[J] = cadd(a, bq); v[J + span] = cmul(csub(a, bq), tw); }
    else { f32x2 tw; if constexpr (ci == 0) tw = w[Q]; else tw = (f32x2){w[Q].x * C32(ci) - w[Q].y * S32(ci), w[Q].y * C32(ci) + w[Q].x * S32(ci)}; const f32x2 a = v[J], bq = cmul(v[J + span], tw); v[J] = cadd(a, bq); v[J + span] = csub(a, bq); } }
}
template <int R, bool INV, int Q, int... J> __device__ __forceinline__ void fft_stage(f32x2 (&v)[1 << R], const f32x2 (&w)[R], std::integer_sequence<int, J...>) { (fft_bfly<R, INV, Q, J>(v, w), ...); }
template <int R, bool INV, int... Q> __device__ __forceinline__ void fft_stages(f32x2 (&v)[1 << R], const f32x2 (&w)[R], std::integer_sequence<int, Q...>) {
  (fft_stage<R, INV, (INV ? R - 1 - Q : Q)>(v, w, std::make_integer_sequence<int, (1 << R)>{}), ...); }
template <int R, int HL, int... J> __device__ __forceinline__ void fft_ld(f32x2 (&v)[1 << R], const LAS f32x2* p, std::integer_sequence<int, J...>) { ((v[J] = p[el_off<HL, J>()]), ...); }
template <int R, int HL, int... J> __device__ __forceinline__ void fft_st(const f32x2 (&v)[1 << R], LAS f32x2* p, std::integer_sequence<int, J...>) { ((p[el_off<HL, J>()] = v[J]), ...); }
template <int R, int... Q> __device__ __forceinline__ void fft_tw(f32x2 (&w)[R], std::integer_sequence<int, Q...>) { ((Q > 0 ? (void)(w[Q] = cmul(w[Q > 0 ? Q - 1 : 0], w[Q > 0 ? Q - 1 : 0])) : (void)0), ...); }
template <int R, int HL, bool INV>
__device__ __forceinline__ void pass(LAS f32x2* zz, const LAS f32x2* TW, int tid) {
  constexpr int RAD = 1 << R, HMIN = 1 << HL, G = HMIN << R;
#pragma unroll 1
  for (int bf = tid; bf < (M >> R); bf += NTHR) {
    const int blk = bf >> HL, off = bf & (HMIN - 1), base = blk * G + off;
    LAS f32x2* p = zz + pad(base);
    f32x2 v[RAD]; fft_ld<R, HL>(v, p, std::make_integer_sequence<int, RAD>{});
    f32x2 w[R];
    w[0] = TW[off << (14 - HL - R)]; if (INV) w[0].y = -w[0].y;
    fft_tw<R>(w, std::make_integer_sequence<int, R>{});
    fft_stages<R, INV>(v, w, std::make_integer_sequence<int, R>{});
    fft_st<R, HL>(v, p, std::make_integer_sequence<int, RAD>{});
  }
}
__device__ __forceinline__ void fft_fwd(LAS f32x2* zz, const LAS f32x2* TW, int tid) {
  pass<5, 9, false>(zz, TW, tid); __syncthreads(); pass<5, 4, false>(zz, TW, tid); __syncthreads(); pass<4, 0, false>(zz, TW, tid); __syncthreads();
}
__device__ __forceinline__ void fft_inv(LAS f32x2* zz, const LAS f32x2* TW, int tid) {
  pass<4, 0, true>(zz, TW, tid); __syncthreads(); pass<5, 4, true>(zz, TW, tid); __syncthreads(); pass<5, 9, true>(zz, TW, tid); __syncthreads();
}
__device__ __forceinline__ void pair_of(int u, int& p, int& pp, int& k) { const int j = 31 - __clz(u); p = (2 << j) + (u - (1 << j)); pp = 3 * (2 << j) - 1 - p; k = (int)(__brev((unsigned)p) >> 18); }
__device__ __forceinline__ void mulstep(LAS f32x2* zz, const f32x2* __restrict__ Kp, const f32x2* __restrict__ TWP, int tid) {
  if (tid == 0) {
    const f32x2 z0 = zz[0], k0 = Kp[0]; const float y0 = (z0.x + z0.y) * k0.x, ym = (z0.x - z0.y) * k0.y; zz[0] = (f32x2){0.5f * (y0 + ym), 0.5f * (y0 - ym)};
    const f32x2 z1 = zz[1]; const f32x2 yq = cmul((f32x2){z1.x, -z1.y}, Kp[1]); zz[1] = (f32x2){yq.x, -yq.y};
  }
#pragma unroll 8
  for (int i = 0; i < 16; ++i) { int u = tid + NTHR * i; u = u == 0 ? 1 : u;
      int p, pp, k; pair_of(u, p, pp, k); const f32x2 W = TWP[u], Kk = Kp[p], Km = Kp[pp]; const int ip = pad(p), ipp = pad(pp);
      const f32x2 Z = zz[ip], Zp = zz[ipp];
      const f32x2 E2 = {fadd_s(Z.x, Zp.x), fsub_s(Z.y, Zp.y)}, O2 = {fadd_s(Z.y, Zp.y), fsub_s(Zp.x, Z.x)};
      const f32x2 WO = cmul(W, O2); const f32x2 Xk = cadd(E2, WO); const f32x2 Xm = {fsub_s(E2.x, WO.x), fsub_s(WO.y, E2.y)};
      const f32x2 Yk = cmul(Xk, Kk), Ym = cmul(Xm, Km);
      const f32x2 Ze = {fadd_s(Yk.x, Ym.x), fsub_s(Yk.y, Ym.y)}; const f32x2 Dd = {fsub_s(Yk.x, Ym.x), fadd_s(Yk.y, Ym.y)};
      const f32x2 Zo = cmul(Dd, (f32x2){W.x, -W.y});
      zz[ip] = (f32x2){fmul_s(0.25f, fsub_s(Ze.x, Zo.y)), fmul_s(0.25f, fadd_s(Ze.y, Zo.x))}; zz[ipp] = (f32x2){fmul_s(0.25f, fadd_s(Ze.x, Zo.y)), fmul_s(0.25f, fsub_s(Zo.x, Ze.y))};
  }
}
__device__ __forceinline__ void filter_unit(const float* __restrict__ KT, f32x2* __restrict__ KF, const f32x2* __restrict__ TWP, Frame& F, int unit) {
  const LAS f32x2* TWS = (const LAS f32x2*)(F.lds + LC_TWS);
  LAS f32x2* zz = (LAS f32x2*)F.lds; LAS float* red = (LAS float*)(F.lds + LC_TP);
  const float* fw = KT + (size_t)unit * SEQ; const float* bw = KT + (size_t)(1024 + unit) * SEQ; const int tid = F.tid;
  float l1 = 0.f;
#pragma unroll
  for (int i = 0; i < 4; ++i) { const int q = tid + NTHR * i;
    const f32x4 a0 = *(const f32x4*)(fw + 8 * q), a1 = *(const f32x4*)(fw + 8 * q + 4);
    const f32x4 c0 = *(const f32x4*)(bw + SEQ - 8 * q - 8), c1 = *(const f32x4*)(bw + SEQ - 8 * q - 4); const float e = q > 0 ? bw[SEQ - 8 * q] : 0.f;
    zz[pad(4 * q + 0)] = (f32x2){a0[0], a0[1]}; zz[pad(4 * q + 1)] = (f32x2){a0[2], a0[3]}; zz[pad(4 * q + 2)] = (f32x2){a1[0], a1[1]}; zz[pad(4 * q + 3)] = (f32x2){a1[2], a1[3]};
    zz[pad(8192 + 4 * q + 0)] = (f32x2){e, c1[3]}; zz[pad(8192 + 4 * q + 1)] = (f32x2){c1[2], c1[1]}; zz[pad(8192 + 4 * q + 2)] = (f32x2){c1[0], c0[3]}; zz[pad(8192 + 4 * q + 3)] = (f32x2){c0[2], c0[1]};
    l1 += (fabsf(a0[0]) + fabsf(a0[1])) + (fabsf(a0[2]) + fabsf(a0[3])) + (fabsf(a1[0]) + fabsf(a1[1])) + (fabsf(a1[2]) + fabsf(a1[3]));
    l1 += (q == 2047 ? 0.f : fabsf(c0[0])) + fabsf(c0[1]) + (fabsf(c0[2]) + fabsf(c0[3])) + (fabsf(c1[0]) + fabsf(c1[1])) + (fabsf(c1[2]) + fabsf(c1[3])); }
  l1 = wave_sum(l1, F.lane); if (F.lane == 0) red[F.wave] = l1;
  __syncthreads();
  float tot = 0.f;
#pragma unroll
  for (int w = 0; w < NWAVES; ++w) tot += red[w];
  const float sc = 1.0f / (tot * (float)M);
  fft_fwd(zz, TWS, tid);
  f32x2* Ko = KF + (size_t)unit * M;
  if (tid == 0) { const f32x2 z0 = zz[0], z1 = zz[1]; Ko[0] = (f32x2){(z0.x + z0.y) * sc, (z0.x - z0.y) * sc}; Ko[1] = (f32x2){z1.x * sc, -z1.y * sc}; }
#pragma unroll 8
  for (int i = 0; i < 16; ++i) { int u = tid + NTHR * i; u = u == 0 ? 1 : u;
      int p, pp, k; pair_of(u, p, pp, k); const f32x2 W = TWP[u]; const f32x2 Z = zz[pad(p)], Zp = zz[pad(pp)];
      const f32x2 E = {0.5f * (Z.x + Zp.x), 0.5f * (Z.y - Zp.y)}, O = {0.5f * (Z.y + Zp.y), -0.5f * (Z.x - Zp.x)};
      const f32x2 WO = cmul(W, O); Ko[p] = (f32x2){(E.x + WO.x) * sc, (E.y + WO.y) * sc}; Ko[pp] = (f32x2){(E.x - WO.x) * sc, -(E.y - WO.y) * sc}; }
  __syncthreads();
}
__device__ __forceinline__ void conv_oct(const bf16* __restrict__ u, int q, float w0, float w1, float w2, float cb, float (&o)[8]) {
  const u32x4 cur = *(const u32x4*)(u + 8 * q); const unsigned prv = q > 0 ? *(const unsigned*)(u + 8 * q - 2) : 0u; const unsigned nxt = q < 2047 ? *(const unsigned*)(u + 8 * q + 8) : 0u;
  float x[10]; x[0] = bfhi(prv); x[1] = bflo(cur.x); x[2] = bfhi(cur.x); x[3] = bflo(cur.y); x[4] = bfhi(cur.y); x[5] = bflo(cur.z); x[6] = bfhi(cur.z); x[7] = bflo(cur.w); x[8] = bfhi(cur.w); x[9] = bflo(nxt);
#pragma unroll
  for (int j = 0; j < 8; ++j) o[j] = w0 * x[j] + w1 * x[j + 1] + w2 * x[j + 2] + cb;
}
__device__ __forceinline__ void hyena_unit(const Args& a, int l, Frame& F, int unit) {
  LAS f32x2* zz = (LAS f32x2*)F.lds; const int tid = F.tid, b = unit >> 9, c = unit & 511;
  const bf16* UT = (const bf16*)(a.ws + WS_UT); const f32x2* KF = (const f32x2*)(a.ws + WS_KF); const f32x2* TW = (const f32x2*)(a.ws + WS_TWP); const LAS f32x2* TWS = (const LAS f32x2*)(F.lds + LC_TWS); bf16* YT = (bf16*)(a.ws + WS_YT);
  const bf16* uv = UT + ((size_t)b * 1536 + c) * SEQ; const bf16* ux1 = uv + (size_t)512 * SEQ; const bf16* ux2 = uv + (size_t)1024 * SEQ;
  const float* cw = a.in[I_CONVW] + l * 3 * 1536; const float* cbv = a.in[I_CONVB] + l * 1536; const float* hd = a.in[I_HD] + l * 1024;
  const float v0 = cw[c], v1 = cw[1536 + c], v2 = cw[3072 + c], vb = cbv[c];
  const float g0 = cw[512 + c], g1 = cw[1536 + 512 + c], g2 = cw[3072 + 512 + c], gb = cbv[512 + c];
  const float h0 = cw[1024 + c], h1 = cw[1536 + 1024 + c], h2 = cw[3072 + 1024 + c], hb = cbv[1024 + c];
  const float d0 = hd[c], d1 = hd[512 + c];
  float zf0 = 0.f; asm volatile("" : "+v"(zf0)); const f32x2 zero2 = {zf0, zf0};
#pragma unroll
  for (int i = 0; i < 4; ++i) { const int q = tid + NTHR * i; float x[8]; conv_oct(uv, q, v0, v1, v2, vb, x);
#pragma unroll
    for (int j = 0; j < 4; ++j) { zz[pad(4 * q + j)] = (f32x2){x[2 * j], x[2 * j + 1]}; zz[pad(8192 + 4 * q + j)] = zero2; } }
  __syncthreads();
#if defined(MK_PROBE_FFT2)
  fft_fwd(zz, TWS, tid); fft_inv(zz, TWS, tid);
  for (int i = tid; i < 17408; i += NTHR) { f32x2 t = zz[i]; t.x *= (1.0f / 16384.0f); t.y *= (1.0f / 16384.0f); zz[i] = t; }
  __syncthreads();
#endif
  fft_fwd(zz, TWS, tid); mulstep(zz, KF + (size_t)c * M, TW, tid); __syncthreads(); fft_inv(zz, TWS, tid);
  float* z1s = (float*)(a.ws + WS_MIX) + (size_t)F.bid * 16384;
#pragma unroll
  for (int i = 0; i < 4; ++i) { const int q = tid + NTHR * i; float x[8], g[8], z[8]; conv_oct(uv, q, v0, v1, v2, vb, x); conv_oct(ux1, q, g0, g1, g2, gb, g);
#pragma unroll
    for (int j = 0; j < 4; ++j) { const f32x2 y = zz[pad(4 * q + j)]; z[2 * j] = g[2 * j] * (y.x + x[2 * j] * d0); z[2 * j + 1] = g[2 * j + 1] * (y.y + x[2 * j + 1] * d0); }
    *(f32x4*)(z1s + 8 * q) = (f32x4){z[0], z[1], z[2], z[3]}; *(f32x4*)(z1s + 8 * q + 4) = (f32x4){z[4], z[5], z[6], z[7]};
#pragma unroll
    for (int j = 0; j < 4; ++j) { zz[pad(4 * q + j)] = (f32x2){z[2 * j], z[2 * j + 1]}; zz[pad(8192 + 4 * q + j)] = zero2; } }
  __syncthreads();
  fft_fwd(zz, TWS, tid); mulstep(zz, KF + (size_t)(512 + c) * M, TW, tid); __syncthreads(); fft_inv(zz, TWS, tid);
  bf16* yo = YT + ((size_t)b * 512 + c) * SEQ;
#pragma unroll
  for (int i = 0; i < 4; ++i) { const int q = tid + NTHR * i; float g[8], o[8]; conv_oct(ux2, q, h0, h1, h2, hb, g); const f32x4 za = *(const f32x4*)(z1s + 8 * q), zb = *(const f32x4*)(z1s + 8 * q + 4);
    const float z[8] = {za[0], za[1], za[2], za[3], zb[0], zb[1], zb[2], zb[3]};
#pragma unroll
    for (int j = 0; j < 4; ++j) { const f32x2 y = zz[pad(4 * q + j)]; o[2 * j] = g[2 * j] * (y.x + z[2 * j] * d1); o[2 * j + 1] = g[2 * j + 1] * (y.y + z[2 * j + 1] * d1); }
    u32x4 w; w.x = pk2(o[0], o[1]); w.y = pk2(o[2], o[3]); w.z = pk2(o[4], o[5]); w.w = pk2(o[6], o[7]); *(u32x4*)(yo + 8 * q) = w; }
  __syncthreads();
}
}
constexpr int NPH = 12, NPHASE = NPH * NLAYER;
#ifndef MK_PHM
#define MK_PHM 0x7FFF
#endif
#ifndef MLA_SDEPTH
#define MLA_SDEPTH 2
#endif
#ifndef MK_SINGLE
#define MK_SINGLE 1
#endif
#ifndef MK_PROBE_SUB
#define MK_PROBE_SUB 0x1010
#endif
#ifndef MK_MLA
#define MK_MLA 1
#endif
#ifndef MK_NA
#define MK_NA 1
#endif
#ifndef MK_HY
#define MK_HY 1
#endif
#ifndef MK_MOE
#define MK_MOE 1
#endif

#if defined(MK_SYNTH)
__device__ __forceinline__ void synth_probe(int iters, const unsigned char* gsrc, LAS unsigned char* ldsl) {
    typedef float f32x16_t __attribute__((ext_vector_type(16)));
    typedef short bf16x8_t __attribute__((ext_vector_type(8)));
    typedef short s16x4_t __attribute__((ext_vector_type(4)));
    f32x16_t c0, c1, c2, c3; bf16x8_t a, b; float t0, t1, t2, t3, t4, t5, t6, t7, y;
    asm volatile("v_mov_b32 %0, 0" : "=v"(y));
    asm volatile("" : "=v"(c0), "=v"(c1), "=v"(c2), "=v"(c3), "=v"(a), "=v"(b));
    asm volatile("" : "=v"(t0), "=v"(t1), "=v"(t2), "=v"(t3), "=v"(t4), "=v"(t5), "=v"(t6), "=v"(t7));
#define SM(C) asm volatile("v_mfma_f32_32x32x16_bf16 %0, %1, %2, %0" : "+v"(C) : "v"(a), "v"(b))
#define SMF(C, F) asm volatile("v_mfma_f32_32x32x16_bf16 %0, %1, %2, %0" : "+v"(C) : "v"(F), "v"(b))
#define SV(X) asm volatile("v_add_f32 %0, %0, %1" : "+v"(X) : "v"(y))
#define SE(X) asm volatile("v_exp_f32 %0, %0" : "+v"(X))
#define SV4() do { SV(t0); SV(t1); SV(t2); SV(t3); } while (0)
#define SV4b() do { SV(t4); SV(t5); SV(t6); SV(t7); } while (0)
#if MK_SYNTH >= 3
    int lane_; asm volatile("v_mbcnt_lo_u32_b32 %0, -1, 0\n\tv_mbcnt_hi_u32_b32 %0, -1, %0" : "=v"(lane_));
    const int r32 = lane_ & 31, hi = lane_ >> 5;
    const int blN = 49152 + r32 * 256 + ((hi ^ (r32 & 15)) << 4), blR = 98304 + r32 * 128 + ((hi ^ ((r32 >> 1) & 7)) << 4);
    const int vb = att::v_rd_base(lane_);
    unsigned wv_; asm volatile("s_mov_b32 %0, 0" : "=s"(wv_));
    const unsigned voff = (unsigned)lane_ * 16u;
#define KRD(F, AD, OFF) asm volatile("ds_read_b128 %0, %1 offset:%2" : "=&v"(F) : "v"(AD), "i"(OFF) : "memory")
#define TRD(F, OFF) asm volatile("ds_read_b64_tr_b16 %0, %1 offset:%2" : "=&v"(F) : "v"(vb), "i"(OFF) : "memory")
#define WT(N) asm volatile("s_waitcnt lgkmcnt(" #N ")" ::: "memory")
#define SMV(C, L, H) do { bf16x8_t f_ = (bf16x8_t){L[0], L[1], L[2], L[3], H[0], H[1], H[2], H[3]}; SMF(C, f_); } while (0)
#endif
#if MK_SYNTH == 5
    bf16x8_t ra0, ra1, ra2, ra3, rb0, rb1;
    { int ln_; asm volatile("v_mbcnt_lo_u32_b32 %0, -1, 0\n\tv_mbcnt_hi_u32_b32 %0, -1, %0" : "=v"(ln_));
      const unsigned* xs = (const unsigned*)gsrc + (size_t)ln_ * 64;
#define RLD(R, O) do { u32x4 w_; w_.x = (xs[O] >> 16) | (xs[O + 1] & 0xffff0000u); w_.y = (xs[O + 2] >> 16) | (xs[O + 3] & 0xffff0000u); w_.z = (xs[O + 4] >> 16) | (xs[O + 5] & 0xffff0000u); w_.w = (xs[O + 6] >> 16) | (xs[O + 7] & 0xffff0000u); R = __builtin_bit_cast(bf16x8_t, w_); asm volatile("" : "+v"(R)); } while (0)
      RLD(ra0, 0); RLD(ra1, 8); RLD(ra2, 16); RLD(ra3, 24); RLD(rb0, 32); RLD(rb1, 40); }
    { f32x16_t z_ = {}; c0 = z_; c1 = z_; c2 = z_; c3 = z_; asm volatile("" : "+v"(c0), "+v"(c1), "+v"(c2), "+v"(c3)); }
#define SMR(C, A, B) asm volatile("v_mfma_f32_32x32x16_bf16 %0, %1, %2, %0" : "+v"(C) : "v"(A), "v"(B))
#endif
#pragma unroll 1
    for (int it = 0; it < iters; ++it) {
#if MK_SYNTH == 1
#pragma unroll
        for (int i = 0; i < 10; ++i) { SM(c0); SV4(); SE(t4); SM(c1); SV4b(); SE(t0); SM(c2); SV4(); SE(t5); SM(c3); SV4b(); if (i < 2) SE(t1); }
#elif MK_SYNTH == 5
#pragma unroll
        for (int i = 0; i < 10; ++i) { SMR(c0, ra0, rb0); SV4(); SE(t4); SMR(c1, ra1, rb1); SV4b(); SE(t0); SMR(c2, ra2, rb0); SV4(); SE(t5); SMR(c3, ra3, rb1); SV4b(); if (i < 2) SE(t1); }
#elif MK_SYNTH == 2
#pragma unroll
        for (int i = 0; i < 6; ++i) { SM(c0); SM(c1); SM(c2); SM(c3); }
#pragma unroll
        for (int i = 0; i < 12; ++i) { SV4(); SV4b(); SE(t0); if (i < 4) SE(t4); }
#pragma unroll
        for (int i = 0; i < 4; ++i) { SM(c0); SM(c1); SM(c2); SM(c3); }
#pragma unroll
        for (int i = 0; i < 8; ++i) { SV4(); SV4b(); SE(t1); SE(t5); }
#else
        { bf16x8_t f0, f1, f2, f3;
#define AD(I) (((I) < 16 ? blN : blR) ^ ((((I) >> 1) & 7) << 5))
#define OF(I) (((I) & 1) ? ((I) < 16 ? 8192 : 4096) : 0)
          KRD(f0, AD(0), 0); KRD(f1, AD(1), 8192); KRD(f2, AD(2), 0);
#define S1(I, FN, FC, CC, WN, TAIL) do { if ((I) + 3 < 24) { if (((I) + 3) & 1) KRD(FN, AD((I) + 3), (((I) + 3) < 16 ? 8192 : 4096)); else KRD(FN, AD((I) + 3), 0); } WT(WN); SMF(CC, FC); TAIL; } while (0)
          S1(0, f3, f0, c0, 3, { SV4(); SE(t4); }); S1(1, f0, f1, c1, 3, { SV4b(); SE(t0); }); S1(2, f1, f2, c0, 3, { SV4(); SE(t5); }); S1(3, f2, f3, c1, 3, { SV4b(); SE(t1); });
          S1(4, f3, f0, c0, 3, { SV4(); SE(t4); }); S1(5, f0, f1, c1, 3, { SV4b(); SE(t0); }); S1(6, f1, f2, c0, 3, { SV4(); SE(t5); }); S1(7, f2, f3, c1, 3, { SV4b(); SE(t1); });
          S1(8, f3, f0, c0, 3, { SV4(); SE(t4); }); S1(9, f0, f1, c1, 3, { SV4b(); SE(t0); }); S1(10, f1, f2, c0, 3, { SV4(); SE(t5); }); S1(11, f2, f3, c1, 3, { SV4b(); SE(t1); });
#if MK_SYNTH == 4
          { const unsigned char* g_ = gsrc + (size_t)(it & 255) * 40960;
#pragma unroll
            for (int q = 0; q < 5; ++q) __builtin_amdgcn_global_load_lds((const unsigned*)(g_ + q * 8192 + voff), (LAS unsigned*)(ldsl + 110000 + q * 8192), 16, 0, 0); }
#endif
          S1(12, f3, f0, c0, 3, { SV4(); SE(t4); }); S1(13, f0, f1, c1, 3, { SV4b(); SE(t0); }); S1(14, f1, f2, c0, 3, { SV4(); SE(t5); }); S1(15, f2, f3, c1, 3, { SV4b(); SE(t1); });
          S1(16, f3, f0, c0, 3, { SV4(); }); S1(17, f0, f1, c1, 3, { SV4b(); }); S1(18, f1, f2, c0, 3, { SV4(); }); S1(19, f2, f3, c1, 3, { SV4b(); });
          S1(20, f3, f0, c0, 3, { SV4(); }); S1(21, f0, f1, c1, 2, { SV4b(); }); S1(22, f1, f2, c0, 1, { SV4(); }); S1(23, f2, f3, c1, 0, { SV4b(); });
          s16x4_t l0, h0, l1, h1, l2, h2, l3, h3;
#define RA(D) do { TRD(l0, (D) * 512); TRD(h0, (D) * 512 + 2048); TRD(l1, (D) * 512 + 4096); TRD(h1, (D) * 512 + 6144); } while (0)
#define RB(D) do { TRD(l2, (D) * 512 + 8192); TRD(h2, (D) * 512 + 10240); TRD(l3, (D) * 512 + 12288); TRD(h3, (D) * 512 + 14336); } while (0)
          RA(0); RB(0);
#define S2(D, WA, WB) do { WT(WA); SMV(c2, l0, h0); SV4(); SE(t4); SMV(c2, l1, h1); SV4b(); SE(t0); if ((D) < 3) RA((D) + 1); WT(WB); SMV(c3, l2, h2); SV4(); SE(t5); SMV(c3, l3, h3); SV4b(); SE(t1); if ((D) < 3) RB((D) + 1); } while (0)
          S2(0, 4, 4); S2(1, 4, 4); S2(2, 4, 4); S2(3, 4, 0);
        }
#endif
#if MK_SYNTH == 4
        asm volatile("s_waitcnt vmcnt(0)" ::: "memory");
#endif
        asm volatile("s_barrier" ::: "memory");
    }
    asm volatile("" :: "v"(c0), "v"(c1), "v"(c2), "v"(c3), "v"(t0), "v"(t1), "v"(t2), "v"(t3), "v"(t4), "v"(t5), "v"(t6), "v"(t7));
}
#endif
template <int PHM> __global__ void __launch_bounds__(NTHR, 2) mk_fwd(Args a_) {
    typedef const __attribute__((address_space(4))) Args* KArgs;
    KArgs ap0 = (KArgs)__builtin_amdgcn_kernarg_segment_ptr();
    extern __shared__ __attribute__((aligned(16))) unsigned char lds[];
#define MKFRAME() Frame F; { int t_ = mk_tid(); asm volatile("" : "+v"(t_)); F.lds = (LAS unsigned char*)lds; F.tid = t_; F.lane = t_ & 63; F.wave = __builtin_amdgcn_readfirstlane(t_ >> 6); \
      F.G = gridDim.x; F.bid = blockIdx.x; F.gw = F.bid * NWAVES + F.wave; F.NGW = F.G * NWAVES; }
    unsigned char* ws0 = ap0->ws;
    if (threadIdx.x < 4) ((LAS unsigned*)((LAS unsigned char*)lds + LC_BAR))[threadIdx.x] = 0u;
    if ((threadIdx.x & 63) == 0) ((LAS int*)((LAS unsigned char*)lds + LC_WID))[(unsigned)__builtin_amdgcn_s_getreg((5 << 11) | 4) & 63u] = (int)(threadIdx.x >> 6);
    __syncthreads();
    XcdBarrier bar; bar.bar = (unsigned*)(ws0 + WS_CTL) + CW_BAR; bar.x = 0; bar.st = nullptr;
    const int lo = ap0->ph_lo, hi = ap0->ph_hi;
    if (hi - lo > 1) bar = xcd_barrier_post((unsigned*)(ws0 + WS_CTL) + CW_BAR, (volatile LAS unsigned*)((LAS unsigned char*)lds + LC_BAR));
#define IN(k) (lo <= (k) && (k) < hi)
#define SEAM(k) do { if (IN(k) && IN((k) + 1)) xcd_barrier(bar); } while (0)
    for (int l = 0; l < NLAYER; ++l) {
        const int pb = l * NPH;
        #if defined(MK_SYNTH)
#if MK_SYNTH == 5
        if (l == 0 && IN(0)) synth_probe(1024, (const unsigned char*)ap0->in[I_X], (LAS unsigned char*)0);
#else
        if (l == 0 && IN(0)) synth_probe(1024, ap0->ws + WS_WGU, (LAS unsigned char*)0);
#endif
#endif
        if (((PHM >> 0) & 1) && IN(pb + 0)) { KArgs ap = ap0; asm volatile("" : "+s"(ap)); const Args& a = *(const Args*)ap; unsigned char* ws = ap->ws; MKFRAME(); ph_prologue(a, l, F); VM_WAIT(); __syncthreads(); }
        SEAM(pb + 0);
        if (((PHM >> 1) & 1) && IN(pb + 1)) { KArgs ap = ap0; asm volatile("" : "+s"(ap)); const Args& a = *(const Args*)ap; unsigned char* ws = ap->ws; MKFRAME();
            pg8::Gemm g{(const pg8::bf16_t*)(ws + WS_XB), (const pg8::bf16_t*)(ws + WS_WIN), T, 4096, DM}; pg8::StaticOrder S; S.init(T, 4096, F.G, F.bid);
            pg8::EpiProj E{(bf16*)(ws + WS_U), (bf16*)(ws + WS_QKV), (bf16*)(ws + WS_CQ), (bf16*)(ws + WS_CKV), (bf16*)(ws + WS_KR)};
            pg8::gemm_phase<pg8::EpiProj, pg8::StaticOrder, true, true>(F.lds, g, S, E);
        }
        SEAM(pb + 1);
        if (((PHM >> 2) & 1) && IN(pb + 2)) { KArgs ap = ap0; asm volatile("" : "+s"(ap)); const Args& a = *(const Args*)ap; unsigned char* ws = ap->ws; MKFRAME();
#if MK_HY
            { const f32x2* TWg = (const f32x2*)(ws + WS_TW); LAS f32x2* TWS = (LAS f32x2*)(F.lds + LC_TWS); for (int i = F.tid; i < 1024; i += NTHR) TWS[i] = TWg[2 * i]; __syncthreads(); }
            for (int u = F.bid; u < 1024; u += F.G) hfft::filter_unit((const float*)(ws + WS_KT), (f32x2*)(ws + WS_KF), (const f32x2*)(ws + WS_TWP), F, u);
#endif
            ph_postproj_waveitems(a, l, F); VM_WAIT(); __syncthreads();
        }
        SEAM(pb + 2);
        if (((PHM >> 3) & 1) && IN(pb + 3)) { KArgs ap = ap0; asm volatile("" : "+s"(ap)); const Args& a = *(const Args*)ap; unsigned char* ws = ap->ws; MKFRAME();
#ifndef P3_NOQ
            { pg8::Gemm g{(const pg8::bf16_t*)(ws + WS_CQ), (const pg8::bf16_t*)(ws + WS_WUQ), T, 1536, 512}; pg8::StaticOrder S; S.init(T, 1536, F.G, F.bid);
              const float* cosT = (const float*)(ws + WS_ROPE);
              pg8::EpiQ E{(bf16*)(ws + WS_QN), (bf16*)(ws + WS_QR), (const float*)(ws + WS_RQ), cosT, cosT + SEQ * 32, QSCALE, SEQ - 1};
              pg8::gemm_phase<pg8::EpiQ, pg8::StaticOrder, true, true>(F.lds, g, S, E); }
#endif
#ifndef P3_NOKV
            { pg8::Gemm g{(const pg8::bf16_t*)(ws + WS_CKV), (const pg8::bf16_t*)(ws + WS_WUKV), T, 2048, 256}; pg8::StaticOrder S; S.init(T, 2048, F.G, F.bid);
              pg8::EpiKV E{(bf16*)(ws + WS_KN), (bf16*)(ws + WS_V), (const float*)(ws + WS_RKV)};
              pg8::gemm_phase<pg8::EpiKV, pg8::StaticOrder, true, true>(F.lds, g, S, E); }
#endif
        }
        SEAM(pb + 3);
        if (((PHM >> 4) & 1) && IN(pb + 4)) { KArgs ap = ap0; asm volatile("" : "+s"(ap)); const Args& a = *(const Args*)ap; unsigned char* ws = ap->ws; MKFRAME();
#if MK_MLA
            if (PHM & 0x1000) for (int u = F.bid; u < 1024; u += F.G) { const int xq_ = ((u >> 8) << 5) + ((u & 255) >> 3), qb = xq_ & 63, h = u & 7, b = xq_ >> 6;     const size_t row0 = (size_t)b * SEQ + qb * 256, key0 = (size_t)b * SEQ;
                att::mla_body2<((PHM >> 16) & 15)>((const bf16*)(ws + WS_QN) + row0 * 1024 + h * 128, (const bf16*)(ws + WS_QR) + row0 * 512 + h * 64, (const bf16*)(ws + WS_KN) + key0 * 1024 + h * 128,
                                 (const bf16*)(ws + WS_KROT) + key0 * 64, (const bf16*)(ws + WS_V) + key0 * 1024 + h * 128, (bf16*)(ws + WS_Y) + row0 * 1536 + 512 + h * 128, 1536, SEQ, (char*)lds, F.lds); }
#else
            { u32x4* y = (u32x4*)(ws + WS_Y); const u32x4 z = {0u, 0u, 0u, 0u}; for (size_t i = (size_t)F.bid * NTHR + F.tid; i < (size_t)T * 128; i += (size_t)F.G * NTHR) { const size_t row = i >> 7, c = i & 127; y[row * 192 + 64 + c] = z; } }
#endif
#if MK_HY
            if (PHM & 0x2000) { { const f32x2* TWg = (const f32x2*)(ws + WS_TW); LAS f32x2* TWS = (LAS f32x2*)(F.lds + LC_TWS); for (int i = F.tid; i < 1024; i += NTHR) TWS[i] = TWg[2 * i]; __syncthreads(); }
              for (int u = F.bid; u < 1024; u += F.G) { const int rnd_ = u / F.G, cc_ = (u % F.G) + F.G * (rnd_ >> 1); hfft::hyena_unit(a, l, F, F.G == 256 ? ((rnd_ & 1) << 9) + cc_ : u); } }
#else
            { u32x4* y = (u32x4*)(ws + WS_YT); const u32x4 z = {0u, 0u, 0u, 0u}; for (size_t i = (size_t)F.bid * NTHR + F.tid; i < (size_t)2 * 512 * SEQ / 8; i += (size_t)F.G * NTHR) y[i] = z; }
#endif
#if MK_NA
            if (PHM & 0x4000) { float* rpbS = (float*)(lds + natt::NA_OFF_RPB); const float* rpb = a.in[I_RPB] + l * 8 * 15 * 31;
              for (int i = F.tid; i < 8 * 15 * 31; i += NTHR) rpbS[i] = rpb[i];
              __syncthreads();
              for (int u = F.gw; u < 2 * 256 * 8 * 2; u += F.NGW) natt::na_unit((const bf16*)(ws + WS_QKV), (bf16*)(ws + WS_Y), rpbS, (char*)lds, u, F.wave, F.lane);
              __syncthreads(); }
#else
            { u32x4* y = (u32x4*)(ws + WS_Y); const u32x4 z = {0u, 0u, 0u, 0u}; for (size_t i = (size_t)F.bid * NTHR + F.tid; i < (size_t)T * 64; i += (size_t)F.G * NTHR) { const size_t row = i >> 6, c = i & 63; y[row * 192 + c] = z; } }
#endif
            VM_WAIT(); __syncthreads();
        }
        SEAM(pb + 4);
        if (((PHM >> 5) & 1) && IN(pb + 5)) { KArgs ap = ap0; asm volatile("" : "+s"(ap)); const Args& a = *(const Args*)ap; unsigned char* ws = ap->ws; MKFRAME(); ph_groupnorm(a, F); VM_WAIT(); __syncthreads(); }
        SEAM(pb + 5);
        if (((PHM >> 6) & 1) && IN(pb + 6)) { KArgs ap = ap0; asm volatile("" : "+s"(ap)); const Args& a = *(const Args*)ap; unsigned char* ws = ap->ws; MKFRAME();
            pg8::Gemm g{(const pg8::bf16_t*)(ws + WS_MIX), (const pg8::bf16_t*)(ws + WS_WOUT), T, DM, DM}; pg8::StaticOrder S; S.init(T, DM, F.G, F.bid);
            pg8::EpiOut E{(const pg8::bf16_t*)(ws + WS_XB), (pg8::bf16_t*)(ws + WS_H1), (f32x2*)(ws + WS_PART), ALPHA};
            pg8::gemm_phase<pg8::EpiOut, pg8::StaticOrder, true, true>(F.lds, g, S, E);
        }
        SEAM(pb + 6);
        if (((PHM >> 7) & 1) && IN(pb + 7)) { KArgs ap = ap0; asm volatile("" : "+s"(ap)); const Args& a = *(const Args*)ap; unsigned char* ws = ap->ws; MKFRAME(); ph_router(a, l, F);
#if defined(MK_PROBE_ROUTER2)
            __syncthreads(); ph_router(a, l, F, 1);
#endif
            VM_WAIT(); __syncthreads(); }
        SEAM(pb + 7);
        if (((PHM >> 9) & 1) && IN(pb + 9)) { KArgs ap = ap0; asm volatile("" : "+s"(ap)); const Args& a = *(const Args*)ap; unsigned char* ws = ap->ws; MKFRAME();
            moe_tables(a, l, F);
            const LAS int* tp = (const LAS int*)(F.lds + LC_TP); const int ntiles = tp[64];
            pg8::Gemm g{(const pg8::bf16_t*)(ws + WS_XM), (const pg8::bf16_t*)(ws + WS_WGU), ntiles * 256, 1024, DM};
            pg8::MoeOrder S{(const LAS int*)(F.lds + LC_TILEE), ntiles, 4, F.G, F.bid, (const pg8::u32x2*)(ws + WS_TABE), tp, (const LAS int*)(F.lds + LC_CNT)};
            pg8::EpiGU E{(bf16*)(ws + WS_HH)};
            pg8::gemm_phase_g<pg8::EpiGU, pg8::MoeOrder, true, true>(F.lds, g, S, E);
        }
        SEAM(pb + 9);
        if (((PHM >> 10) & 1) && IN(pb + 10)) { KArgs ap = ap0; asm volatile("" : "+s"(ap)); const Args& a = *(const Args*)ap; unsigned char* ws = ap->ws; MKFRAME();
            moe_tables(a, l, F);
            const LAS int* tp = (const LAS int*)(F.lds + LC_TP); const int ntiles = tp[64];
            pg8::Gemm g{(const pg8::bf16_t*)(ws + WS_HH), (const pg8::bf16_t*)(ws + WS_WDN), ntiles * 256, 2048, 512};
            pg8::MoeOrder S{(const LAS int*)(F.lds + LC_TILEE), ntiles, 8, F.G, F.bid, (const pg8::u32x2*)(ws + WS_TABE), tp, (const LAS int*)(F.lds + LC_CNT)};
            pg8::EpiDown E{(bf16*)(ws + WS_FF), (const pg8::u32x2*)(ws + WS_TABE), tp, (const LAS int*)(F.lds + LC_CNT)};
            pg8::gemm_phase<pg8::EpiDown, pg8::MoeOrder, true, true>(F.lds, g, S, E);
        }
        SEAM(pb + 10);
        if (((PHM >> 11) & 1) && IN(pb + 11)) { KArgs ap = ap0; asm volatile("" : "+s"(ap)); const Args& a = *(const Args*)ap; unsigned char* ws = ap->ws; MKFRAME(); ph_combine(a, l, F); VM_WAIT(); __syncthreads(); }
        SEAM(pb + 11);
    }
#undef IN
#undef SEAM
}

extern "C" void kernel_launch(void* const* d_in, const int* in_sizes, int n_in, void* d_out, int out_size, void* d_ws, size_t ws_size, hipStream_t stream) {
    static int grid = 0;
    if (grid == 0) {
        if (n_in != 28 || out_size != T * DM || ws_size < WS_END) { fprintf(stderr, "kernel_launch: unexpected shapes (n_in %d, out %d, ws %zu)\n", n_in, out_size, ws_size); grid = -1; return; }
        int dev = 0, cus = 0, per_cu = 0;
        if (hipGetDevice(&dev) != hipSuccess || hipDeviceGetAttribute(&cus, hipDeviceAttributeMultiprocessorCount, dev) != hipSuccess) { grid = -1; return; }
#if defined(MK_PROBE_DUP)
        const void* fns[2] = {(const void*)mk_fwd<MK_PHM>, (const void*)mk_fwd<MK_PROBE_SUB>}; const int nfn = 2;
#else
        const void* fns[1] = {(const void*)mk_fwd<MK_PHM>}; const int nfn = 1;
#endif
        for (int i = 0; i < nfn; ++i) if (hipFuncSetAttribute(fns[i], hipFuncAttributeMaxDynamicSharedMemorySize, LDS_BYTES) != hipSuccess) { fprintf(stderr, "kernel_launch: hipFuncSetAttribute failed\n"); grid = -1; return; }
        if (hipOccupancyMaxActiveBlocksPerMultiprocessor(&per_cu, fns[0], NTHR, LDS_BYTES) != hipSuccess || per_cu < 1) fprintf(stderr, "kernel_launch: occupancy query says %d\n", per_cu);
        (void)hipGetLastError();
        grid = cus;
    }
    if (grid < 0) return;
    if (hipMemsetAsync((char*)d_ws + WS_CTL, 0, CTL_ZERO_BYTES, stream) != hipSuccess) return;
    Args a{};
    for (int i = 0; i < 28; ++i) a.in[i] = (const float*)d_in[i];
    a.out = (float*)d_out; a.ws = (unsigned char*)d_ws;
#if defined(MK_PROBE_DUP)
    for (int p = 0; p < NPHASE; ++p) { a.ph_lo = p; a.ph_hi = p + 1; const int k = p % NPH;
#if defined(MK_PROBE_PRE)
        if (((MK_PROBE_DUP >> k) & 1) && k == 4 && p < NPH) hipLaunchKernelGGL(mk_fwd<MK_PROBE_SUB>, dim3(grid), dim3(NTHR), LDS_BYTES, stream, a);
        hipLaunchKernelGGL(mk_fwd<MK_PHM>, dim3(grid), dim3(NTHR), LDS_BYTES, stream, a); continue;
#endif
        hipLaunchKernelGGL(mk_fwd<MK_PHM>, dim3(grid), dim3(NTHR), LDS_BYTES, stream, a);
        if ((MK_PROBE_DUP >> k) & 1) { if (k == 4) hipLaunchKernelGGL(mk_fwd<MK_PROBE_SUB>, dim3(grid), dim3(NTHR), LDS_BYTES, stream, a); else hipLaunchKernelGGL(mk_fwd<MK_PHM>, dim3(grid), dim3(NTHR), LDS_BYTES, stream, a); } }
#elif MK_SINGLE
    a.ph_lo = 0; a.ph_hi = NPHASE;
    hipLaunchKernelGGL(mk_fwd<MK_PHM>, dim3(grid), dim3(NTHR), LDS_BYTES, stream, a);
#else
    for (int p = 0; p < NPHASE; ++p) { a.ph_lo = p; a.ph_hi = p + 1; hipLaunchKernelGGL(mk_fwd<MK_PHM>, dim3(grid), dim3(NTHR), LDS_BYTES, stream, a); }
#endif
}
```

```cpp
#include <hip/hip_runtime.h>
#include <cstdio>
#include <cstdint>
#include <utility>
#define LAS __attribute__((address_space(3)))
constexpr int LC_WID = 157696 + 2048;
__device__ __forceinline__ int mk_tid() {
    int lane; asm volatile("v_mbcnt_lo_u32_b32 %0, -1, 0\n\tv_mbcnt_hi_u32_b32 %0, -1, %0" : "=v"(lane));
    const unsigned hw = (unsigned)__builtin_amdgcn_s_getreg((5 << 11) | 4) & 63u;
    const int wv = ((const LAS int*)(unsigned)LC_WID)[hw];
    return wv * 64 + lane;
}
__device__ __forceinline__ float shx(float v, int o, int lane) { return __builtin_bit_cast(float, __builtin_amdgcn_ds_bpermute((lane ^ o) << 2, __builtin_bit_cast(int, v))); }
__device__ __forceinline__ int shup_i(int v, int o, int lane) { return __builtin_amdgcn_ds_bpermute(((lane - o) & 63) << 2, v); }
__device__ __forceinline__ float fadd_s(float a, float b) { float r; asm("v_add_f32_e32 %0, %1, %2" : "=v"(r) : "v"(a), "v"(b)); return r; }
__device__ __forceinline__ float fsub_s(float a, float b) { float r; asm("v_sub_f32_e32 %0, %1, %2" : "=v"(r) : "v"(a), "v"(b)); return r; }
__device__ __forceinline__ float fmul_s(float a, float b) { float r; asm("v_mul_f32_e32 %0, %1, %2" : "=v"(r) : "v"(a), "v"(b)); return r; }
__device__ __forceinline__ float ffma_s(float a, float b, float c) { float r; asm("v_fma_f32 %0, %1, %2, %3" : "=v"(r) : "v"(a), "v"(b), "v"(c)); return r; }
__device__ __forceinline__ float ffnma_s(float a, float b, float c) { float r; asm("v_fma_f32 %0, %1, %2, -%3" : "=v"(r) : "v"(a), "v"(b), "v"(c)); return r; }
namespace pg8 {
#define PG8_LAS __attribute__((address_space(3)))
typedef unsigned short bf16_t;
typedef short bf16x8 __attribute__((ext_vector_type(8)));
typedef float f32x4 __attribute__((ext_vector_type(4)));
typedef unsigned u32x4 __attribute__((ext_vector_type(4)));
constexpr int BM = 256, BK = 64, HALF = 128, HTB = HALF * BK * 2  , STAGE_BYTES = 8 * HTB, NXCD = 8, WGM = 8;

__host__ __device__ __forceinline__ int lds_byte(int r, int c) { const int st = (r >> 4) * 2 + (c >> 5), rr = r & 15, cc = c & 31, ob = rr * 64 + cc * 2; return st * 1024 + (ob ^ (((ob >> 9) & 1) << 5)); }
__host__ __device__ __forceinline__ void stage_rc(int b, int& R, int& C) { const int st = b / 1024, sb = b % 1024, swz = sb ^ (((sb >> 9) & 1) << 5); R = (st >> 1) * 16 + swz / 64; C = (st & 1) * 32 + (swz % 64) / 2; }
__host__ __device__ __forceinline__ int perm32(int rho) { const int n = rho >> 4, i = rho & 15; return 8 * (i >> 2) + 4 * n + (i & 3); }

struct Unit { int pm, pn; };
struct Gemm { const bf16_t* A; const bf16_t* Bt; int M, N, K; };

struct StaticOrder {
    int nM, nN, nwg, G, c;
    __host__ __device__ void init(int M, int N, int G_, int c_) { nM = M / BM; nN = N / BM; nwg = nM * nN; G = G_; c = c_; }
    __host__ __device__ bool next(int i, Unit& u) const {
        const long L = (long)i * G + c; if (L >= nwg) return false;
        int wgid = (int)L; { const int q = nwg / NXCD, r = nwg % NXCD, xcd = wgid % NXCD, off = wgid / NXCD; wgid = (xcd < r ? xcd * (q + 1) : r * (q + 1) + (xcd - r) * q) + off; }
        const int nig = WGM * nN, gid = wgid / nig, fm = gid * WGM, gsz = (nM - fm) < WGM ? (nM - fm) : WGM;
        u.pm = fm + ((wgid % nig) % gsz); u.pn = (wgid % nig) / gsz; return true;
    }
    __device__ __forceinline__ void a_ready(const Unit&) const {}
    __device__ __forceinline__ void done(const Unit&) const {}
};
__device__ __forceinline__ unsigned cvt_pk_bf16(float lo, float hi) { unsigned r; asm volatile("v_cvt_pk_bf16_f32 %0, %1, %2" : "=v"(r) : "v"(lo), "v"(hi)); return r; }
typedef unsigned u32x2 __attribute__((ext_vector_type(2)));
struct MoeOrder {
    const PG8_LAS int* tile_e; int ntiles, NTN, G, c; const u32x2* tabE; const PG8_LAS int* tp; const PG8_LAS int* cnt;
    __device__ __forceinline__ int arow(const Unit& u, int r) const { const int e = tile_e[u.pm], p = 256 * (u.pm - tp[e]) + r; return p < cnt[e] ? (int)(tabE[(size_t)e * 32768 + p].x >> 1) : 0; }
    __device__ __forceinline__ bool next(int i, Unit& u) const {
        int tm, pl;
        if (G == 256) {
            const int xcd = c & 7, slot = c >> 3, rpr = 256 / NTN; tm = i * rpr + xcd * (rpr >> 3) + slot / NTN; pl = slot % NTN; if (tm >= ntiles) return false; }
        else { const long Lx = (long)i * G + c; if (Lx >= (long)ntiles * NTN) return false; tm = (int)(Lx / NTN); pl = (int)(Lx % NTN); }
        u.pm = tm; u.pn = tile_e[tm] * NTN + pl; return true;
    }
    __device__ __forceinline__ void a_ready(const Unit&) const {}
    __device__ __forceinline__ void done(const Unit&) const {}
};
__device__ __forceinline__ u32x4 pack8(const f32x4 v0, const f32x4 v1) { u32x4 w; w.x = cvt_pk_bf16(v0[0], v0[1]); w.y = cvt_pk_bf16(v0[2], v0[3]); w.z = cvt_pk_bf16(v1[0], v1[1]); w.w = cvt_pk_bf16(v1[2], v1[3]); return w; }
typedef float f32x2 __attribute__((ext_vector_type(2)));
__device__ __forceinline__ u32x2 pack4(const f32x4 v) { u32x2 w; w.x = cvt_pk_bf16(v[0], v[1]); w.y = cvt_pk_bf16(v[2], v[3]); return w; }

struct EpiProj {
    static constexpr bool PERM = true, AFTER_DRAIN = false;
    bf16_t *U, *QKV, *CQ, *CKV, *KR;
    __device__ __forceinline__ void operator()(const f32x4 (&acc)[2][2][4][2], const Unit& u, int wr, int wc, int fr, int fq) const {
        const int pn = u.pn; bf16_t* base; int ldc, colt, ncols = 256;
        if (pn < 6) { base = U; ldc = 1536; colt = pn * 256; }
        else if (pn < 12) { base = QKV; ldc = 1536; colt = (pn - 6) * 256; }
        else if (pn < 14) { base = CQ; ldc = 512; colt = (pn - 12) * 256; }
        else if (pn == 14) { base = CKV; ldc = 256; colt = 0; }
        else { base = KR; ldc = 64; colt = 0; ncols = 64; }
        const int row0 = u.pm * BM + wr * 64 + fr, cin = wc * 32 + 8 * fq;
#pragma unroll
        for (int ai = 0; ai < 2; ++ai)
#pragma unroll
            for (int m = 0; m < 4; ++m) { bf16_t* rowp = base + (size_t)(row0 + ai * HALF + m * 16) * ldc + colt + cin;
#pragma unroll
                for (int bj = 0; bj < 2; ++bj) if (bj * HALF + cin < ncols) *(u32x4*)(rowp + bj * HALF) = pack8(acc[ai][bj][m][0], acc[ai][bj][m][1]);
                asm volatile("" ::: "memory"); }
    }
};
struct EpiQ {
    static constexpr bool PERM = false, AFTER_DRAIN = false;
    bf16_t *QN, *QR; const float* rq; const float* cosT; const float* sinT; float qscale; int Lmask;
    __device__ __forceinline__ void operator()(const f32x4 (&acc)[2][2][4][2], const Unit& u, int wr, int wc, int fr, int fq) const {
        const int row0 = u.pm * BM + wr * 64 + fr, pn = u.pn;
        float sc[2][4];
#pragma unroll
        for (int ai = 0; ai < 2; ++ai)
#pragma unroll
            for (int m = 0; m < 4; ++m) sc[ai][m] = rq[row0 + ai * HALF + m * 16];
#pragma unroll
        for (int ai = 0; ai < 2; ++ai)
#pragma unroll
            for (int m = 0; m < 4; ++m) { const int row = row0 + ai * HALF + m * 16; const float s = sc[ai][m] * qscale;
                if (pn < 4) { bf16_t* rowp = QN + (size_t)row * 1024 + pn * 256 + wc * 32 + 4 * fq;
#pragma unroll
                    for (int bj = 0; bj < 2; ++bj)
#pragma unroll
                        for (int n = 0; n < 2; ++n) *(u32x2*)(rowp + bj * HALF + n * 16) = pack4(acc[ai][bj][m][n] * s);
                } else { const int head = (pn - 4) * 4 + wc, pos = row & Lmask; bf16_t* rowp = QR + (size_t)row * 512 + head * 64 + 4 * fq;
#pragma unroll
                    for (int n = 0; n < 2; ++n) { const int d = n * 16 + 4 * fq; const f32x4 c4 = *(const f32x4*)(cosT + pos * 32 + d), s4 = *(const f32x4*)(sinT + pos * 32 + d);
                        const f32x4 x1 = acc[ai][0][m][n] * s, x2 = acc[ai][1][m][n] * s;
                        *(u32x2*)(rowp + n * 16) = pack4(x1 * c4 - x2 * s4); *(u32x2*)(rowp + 32 + n * 16) = pack4(x1 * s4 + x2 * c4); asm volatile("" ::: "memory"); } }
                asm volatile("" ::: "memory");
            }
    }
};
struct EpiKV {
    static constexpr bool PERM = true, AFTER_DRAIN = false;
    bf16_t *KN, *V; const float* rkv;
    __device__ __forceinline__ void operator()(const f32x4 (&acc)[2][2][4][2], const Unit& u, int wr, int wc, int fr, int fq) const {
        const int pn = u.pn; bf16_t* base = pn < 4 ? KN : V; const int colt = (pn & 3) * 256 + wc * 32 + 8 * fq, row0 = u.pm * BM + wr * 64 + fr;
        float sc[2][4];
#pragma unroll
        for (int ai = 0; ai < 2; ++ai)
#pragma unroll
            for (int m = 0; m < 4; ++m) sc[ai][m] = rkv[row0 + ai * HALF + m * 16];
#pragma unroll
        for (int ai = 0; ai < 2; ++ai)
#pragma unroll
            for (int m = 0; m < 4; ++m) { const int row = row0 + ai * HALF + m * 16; const float s = sc[ai][m]; bf16_t* rowp = base + (size_t)row * 1024 + colt;
#pragma unroll
                for (int bj = 0; bj < 2; ++bj) *(u32x4*)(rowp + bj * HALF) = pack8(acc[ai][bj][m][0] * s, acc[ai][bj][m][1] * s);
                asm volatile("" ::: "memory"); }
    }
};
struct EpiOut {
    static constexpr bool PERM = true, AFTER_DRAIN = false;
    const bf16_t* xres; bf16_t* H1; f32x2* part; float alpha;
    __device__ __forceinline__ void operator()(const f32x4 (&acc)[2][2][4][2], const Unit& u, int wr, int wc, int fr, int fq) const {
        const int row0 = u.pm * BM + wr * 64 + fr, col0 = u.pn * BM + wc * 32 + 8 * fq;
#pragma unroll
        for (int ai = 0; ai < 2; ++ai) {
            u32x4 xr[1][4][2];
#pragma unroll
            for (int m = 0; m < 4; ++m)
#pragma unroll
                for (int bj = 0; bj < 2; ++bj) xr[0][m][bj] = *(const u32x4*)(xres + (size_t)(row0 + ai * HALF + m * 16) * 2048 + col0 + bj * HALF);
            asm volatile("" ::: "memory");
#pragma unroll
            for (int m = 0; m < 4; ++m) { const int row = row0 + ai * HALF + m * 16; const size_t off = (size_t)row * 2048 + col0; float s = 0.f, q = 0.f;
#pragma unroll
                for (int bj = 0; bj < 2; ++bj) { const u32x4 xw = xr[0][m][bj];
                    f32x4 h0, h1;
                    h0[0] = __uint_as_float(xw.x << 16) * alpha + acc[ai][bj][m][0][0]; h0[1] = __uint_as_float(xw.x & 0xffff0000u) * alpha + acc[ai][bj][m][0][1];
                    h0[2] = __uint_as_float(xw.y << 16) * alpha + acc[ai][bj][m][0][2]; h0[3] = __uint_as_float(xw.y & 0xffff0000u) * alpha + acc[ai][bj][m][0][3];
                    h1[0] = __uint_as_float(xw.z << 16) * alpha + acc[ai][bj][m][1][0]; h1[1] = __uint_as_float(xw.z & 0xffff0000u) * alpha + acc[ai][bj][m][1][1];
                    h1[2] = __uint_as_float(xw.w << 16) * alpha + acc[ai][bj][m][1][2]; h1[3] = __uint_as_float(xw.w & 0xffff0000u) * alpha + acc[ai][bj][m][1][3];
                    *(u32x4*)(H1 + off + bj * HALF) = pack8(h0, h1);
                    s += ((h0[0] + h0[1]) + (h0[2] + h0[3])) + ((h1[0] + h1[1]) + (h1[2] + h1[3]));
                    q += ((h0[0] * h0[0] + h0[1] * h0[1]) + (h0[2] * h0[2] + h0[3] * h0[3])) + ((h1[0] * h1[0] + h1[1] * h1[1]) + (h1[2] * h1[2] + h1[3] * h1[3])); }
                { const int ln = fq * 16 + fr; s += shx(s, 16, ln); s += shx(s, 32, ln); q += shx(q, 16, ln); q += shx(q, 32, ln); }
                if (fq == 0) part[(size_t)row * 32 + u.pn * 4 + wc] = (f32x2){s, q};
                asm volatile("" ::: "memory"); }
        }
    }
};
struct EpiGU {
    static constexpr bool PERM = true, AFTER_DRAIN = false;
    bf16_t* HH;
    __device__ __forceinline__ void operator()(const f32x4 (&acc)[2][2][4][2], const Unit& u, int wr, int wc, int fr, int fq) const {
        const int row0 = u.pm * BM + wr * 64 + fr, colt = (u.pn & 3) * 128 + wc * 32 + 8 * fq;
#pragma unroll
        for (int ai = 0; ai < 2; ++ai)
#pragma unroll
            for (int m = 0; m < 4; ++m) { bf16_t* rowp = HH + (size_t)(row0 + ai * HALF + m * 16) * 512 + colt; f32x4 h[2];
#pragma unroll
                for (int n = 0; n < 2; ++n) { const f32x4 g = acc[ai][0][m][n], up = acc[ai][1][m][n];
#pragma unroll
                    for (int j = 0; j < 4; ++j) h[n][j] = g[j] * __builtin_amdgcn_rcpf(1.0f + __expf(-g[j])) * up[j]; }
                *(u32x4*)rowp = pack8(h[0], h[1]); asm volatile("" ::: "memory"); }
    }
};
struct EpiDown {
    static constexpr bool PERM = true, AFTER_DRAIN = false;
    bf16_t* FF; const u32x2* tabE; const PG8_LAS int* tp; const PG8_LAS int* cnt;
    __device__ __forceinline__ void operator()(const f32x4 (&acc)[2][2][4][2], const Unit& u, int wr, int wc, int fr, int fq) const {
        const int e = u.pn >> 3, colt = (u.pn & 7) * 256 + wc * 32 + 8 * fq, p0 = 256 * (u.pm - tp[e]), lim = cnt[e] - p0; const u32x2* tb = tabE + (size_t)e * 32768 + p0;
        u32x2 te[2][4];
#pragma unroll
        for (int ai = 0; ai < 2; ++ai)
#pragma unroll
            for (int m = 0; m < 4; ++m) { const int lr = wr * 64 + fr + ai * HALF + m * 16; te[ai][m] = (u32x2){0u, 0u}; if (lr < lim) te[ai][m] = tb[lr]; }
#pragma unroll
        for (int ai = 0; ai < 2; ++ai)
#pragma unroll
            for (int m = 0; m < 4; ++m) { const int lr = wr * 64 + fr + ai * HALF + m * 16;
                if (lr < lim) { const u32x2 t2 = te[ai][m]; const int ri = (int)t2.x; const float w = __uint_as_float(t2.y); bf16_t* rowp = FF + (size_t)ri * 2048 + colt;
#pragma unroll
                    for (int bj = 0; bj < 2; ++bj) *(u32x4*)(rowp + bj * HALF) = pack8(acc[ai][bj][m][0] * w, acc[ai][bj][m][1] * w); }
                asm volatile("" ::: "memory"); }
    }
};
template <class Epi, class Sched, bool ALIGN_EPI = false, bool SP2 = false>
__device__ __forceinline__ void gemm_phase(PG8_LAS unsigned char* lds, const Gemm g, const Sched& S, const Epi& E) {
    int tid_ = mk_tid(); asm volatile("" : "+v"(tid_));
    const int tid = tid_, wid = __builtin_amdgcn_readfirstlane(tid >> 6), lane = tid & 63, wr = wid >> 2, wc = wid & 3, fr = lane & 15, fq = lane >> 4;
    const int K = g.K, nt = K / BK;
    unsigned voffA[2], voffB[2];
#pragma unroll
    for (int i = 0; i < 2; ++i) { int R, C; stage_rc(tid * 16 + i * 8192, R, C); const int Rb = Epi::PERM ? ((R & ~31) + perm32(R & 31)) : R;
        voffA[i] = (unsigned)(R * K + C) * 2u; voffB[i] = (unsigned)(Rb * K + C) * 2u; }
    const size_t kstep = (size_t)(BK * 2);
    const size_t hstep = (size_t)HALF * K * 2;
    const size_t tstep = 2 * hstep;
    const unsigned ldsw = (unsigned)wid * 1024u;
    const int aoff = lds_byte(wr * 64 + fr, fq * 8), boff = lds_byte(wc * 32 + fr, fq * 8);
#define PG8_SA(b, h) (((b) * 2 + (h)) * HTB)
#define PG8_SB(b, h) ((4 + (b) * 2 + (h)) * HTB)
#define PG8_STAGE(bufoff, gbase, voff) do { _Pragma("unroll") for (int _i = 0; _i < 2; ++_i) \
        __builtin_amdgcn_global_load_lds((const unsigned*)((const char*)(gbase) + (voff)[_i]), (PG8_LAS unsigned*)(lds + (bufoff) + ldsw + _i * 8192), 16, 0, 0); } while (0)
#define PG8_LDA(dst, b, h) do { _Pragma("unroll") for (int m = 0; m < 4; ++m) _Pragma("unroll") for (int k = 0; k < 2; ++k) dst[m][k] = *(const PG8_LAS bf16x8*)(lds + PG8_SA(b, h) + aoff + m * 2048 + k * 1024); } while (0)
#define PG8_LDB(dst, b, h) do { _Pragma("unroll") for (int n = 0; n < 2; ++n) _Pragma("unroll") for (int k = 0; k < 2; ++k) dst[n][k] = *(const PG8_LAS bf16x8*)(lds + PG8_SB(b, h) + boff + n * 2048 + k * 1024); } while (0)
#define PG8_MMA(ai, bj, At, Bt) do { __builtin_amdgcn_s_setprio(1); _Pragma("unroll") for (int m = 0; m < 4; ++m) _Pragma("unroll") for (int n = 0; n < 2; ++n) _Pragma("unroll") for (int k = 0; k < 2; ++k) \
        acc[ai][bj][m][n] = __builtin_amdgcn_mfma_f32_16x16x32_bf16(Bt[n][k], At[m][k], acc[ai][bj][m][n], 0, 0, 0); __builtin_amdgcn_s_setprio(0); } while (0)
#define PG8_WAIT_V(n) asm volatile("s_waitcnt vmcnt(" #n ")" ::: "memory")
#define PG8_WAIT_L(n) asm volatile("s_waitcnt lgkmcnt(" #n ")" ::: "memory")
#define PG8_BAR __builtin_amdgcn_s_barrier()
#define PG8_SCHED __builtin_amdgcn_sched_barrier(0)
    Unit cur, nxt; int ui = 0;
    float zf_ = 0.f; asm volatile("" : "+v"(zf_));
    if (!S.next(0, cur)) return;
    f32x4 acc[2][2][4][2];
#pragma unroll
    for (int a = 0; a < 2; ++a)
#pragma unroll
        for (int b = 0; b < 2; ++b)
#pragma unroll
            for (int m = 0; m < 4; ++m)
#pragma unroll
                for (int n = 0; n < 2; ++n) acc[a][b][m][n] = (f32x4){zf_, zf_, zf_, zf_};
    bf16x8 At[4][2], B0[2][2], B1[2][2];
    const char* cA = (const char*)g.A + (size_t)cur.pm * tstep; const char* cB = (const char*)g.Bt + (size_t)cur.pn * tstep;
    S.a_ready(cur);
    if constexpr (SP2) {
        PG8_STAGE(PG8_SB(0, 0), cB, voffB); PG8_STAGE(PG8_SB(0, 1), cB + hstep, voffB); PG8_STAGE(PG8_SA(0, 0), cA, voffA); PG8_STAGE(PG8_SA(0, 1), cA + hstep, voffA);
        if (wr == 1) PG8_BAR;
        PG8_WAIT_V(2); PG8_BAR;
        PG8_STAGE(PG8_SB(1, 0), cB + kstep, voffB); PG8_STAGE(PG8_SA(1, 0), cA + kstep, voffA); PG8_STAGE(PG8_SB(1, 1), cB + hstep + kstep, voffB);
        PG8_WAIT_V(6); PG8_BAR;
    } else {
        PG8_STAGE(PG8_SB(0, 0), cB, voffB); PG8_STAGE(PG8_SA(0, 0), cA, voffA); PG8_STAGE(PG8_SB(0, 1), cB + hstep, voffB); PG8_STAGE(PG8_SA(0, 1), cA + hstep, voffA);
        if (wr == 1) PG8_BAR;
        PG8_WAIT_V(4); PG8_BAR;
        PG8_STAGE(PG8_SB(1, 0), cB + kstep, voffB); PG8_STAGE(PG8_SA(1, 0), cA + kstep, voffA); PG8_STAGE(PG8_SB(1, 1), cB + hstep + kstep, voffB);
        PG8_WAIT_V(6); PG8_BAR;
    }
    for (;;) {
        const bool has_next = S.next(ui + 1, nxt);
        const char* nA = has_next ? (const char*)g.A + (size_t)nxt.pm * tstep : cA; const char* nB = has_next ? (const char*)g.Bt + (size_t)nxt.pn * tstep : cB;
#pragma unroll 1
        for (int t = 0; t < nt; t += 2) {
            const bool last = (t == nt - 2);
            const char* a1 = cA + (size_t)(t + 1) * kstep;
            const char* a2 = last ? nA : cA + (size_t)(t + 2) * kstep; const char* b2 = last ? nB : cB + (size_t)(t + 2) * kstep;
            const char* a3 = a2 + kstep; const char* b3 = b2 + kstep;
            if (last && has_next) S.a_ready(nxt);
            if constexpr (SP2) {
            PG8_LDB(B0, 0, 0); PG8_LDB(B1, 0, 1); PG8_SCHED; PG8_LDA(At, 0, 0); PG8_STAGE(PG8_SA(1, 1), a1 + hstep, voffA);
            PG8_WAIT_V(8); PG8_WAIT_L(0); PG8_BAR; PG8_MMA(0, 0, At, B0); PG8_MMA(0, 1, At, B1); PG8_BAR; PG8_SCHED;
            PG8_LDA(At, 0, 1); PG8_STAGE(PG8_SB(0, 0), b2, voffB); PG8_STAGE(PG8_SB(0, 1), b2 + hstep, voffB); PG8_STAGE(PG8_SA(0, 0), a2, voffA);
            PG8_WAIT_V(8); PG8_WAIT_L(0); PG8_BAR; PG8_MMA(1, 0, At, B0); PG8_MMA(1, 1, At, B1); PG8_BAR; PG8_SCHED;
            PG8_LDB(B0, 1, 0); PG8_LDB(B1, 1, 1); PG8_SCHED; PG8_LDA(At, 1, 0); PG8_STAGE(PG8_SA(0, 1), a2 + hstep, voffA);
            PG8_WAIT_V(8); PG8_WAIT_L(0); PG8_BAR; PG8_MMA(0, 0, At, B0); PG8_MMA(0, 1, At, B1); PG8_BAR; PG8_SCHED;
            PG8_LDA(At, 1, 1); PG8_STAGE(PG8_SB(1, 0), b3, voffB); PG8_STAGE(PG8_SB(1, 1), b3 + hstep, voffB); PG8_STAGE(PG8_SA(1, 0), a3, voffA);
            PG8_WAIT_V(8); PG8_WAIT_L(0); PG8_BAR; PG8_MMA(1, 0, At, B0); PG8_MMA(1, 1, At, B1); PG8_BAR; PG8_SCHED;
            } else {
            PG8_LDB(B0, 0, 0); PG8_SCHED; PG8_LDA(At, 0, 0); PG8_STAGE(PG8_SA(1, 1), a1 + hstep, voffA);
            PG8_WAIT_L(8); PG8_BAR; PG8_WAIT_L(0); PG8_MMA(0, 0, At, B0); PG8_BAR; PG8_SCHED;
            PG8_LDB(B1, 0, 1); PG8_STAGE(PG8_SB(0, 0), b2, voffB);
            PG8_BAR; PG8_WAIT_L(0); PG8_MMA(0, 1, At, B1); PG8_BAR;
            PG8_LDA(At, 0, 1); PG8_STAGE(PG8_SA(0, 0), a2, voffA);
            PG8_BAR; PG8_WAIT_L(0); PG8_MMA(1, 0, At, B0); PG8_BAR; PG8_SCHED;
            PG8_STAGE(PG8_SB(0, 1), b2 + hstep, voffB);
            PG8_WAIT_V(6); PG8_BAR; PG8_MMA(1, 1, At, B1); PG8_BAR;
            PG8_LDB(B0, 1, 0); PG8_SCHED; PG8_LDA(At, 1, 0); PG8_STAGE(PG8_SA(0, 1), a2 + hstep, voffA);
            PG8_WAIT_L(8); PG8_BAR; PG8_WAIT_L(0); PG8_MMA(0, 0, At, B0); PG8_BAR; PG8_SCHED;
            PG8_LDB(B1, 1, 1); PG8_STAGE(PG8_SB(1, 0), b3, voffB);
            PG8_BAR; PG8_WAIT_L(0); PG8_MMA(0, 1, At, B1); PG8_BAR;
            PG8_LDA(At, 1, 1); PG8_STAGE(PG8_SA(1, 0), a3, voffA);
            PG8_BAR; PG8_WAIT_L(0); PG8_MMA(1, 0, At, B0); PG8_BAR; PG8_SCHED;
            PG8_STAGE(PG8_SB(1, 1), b3 + hstep, voffB);
            PG8_WAIT_V(6); PG8_BAR; PG8_MMA(1, 1, At, B1); PG8_BAR;
            }
        }
        if constexpr (ALIGN_EPI) { if (wr == 0) PG8_BAR; }
        if constexpr (!Epi::AFTER_DRAIN) { E(acc, cur, wr, wc, fr, fq); S.done(cur); }
        if (!has_next) break;
#pragma unroll
        for (int a = 0; a < 2; ++a)
#pragma unroll
            for (int b = 0; b < 2; ++b)
#pragma unroll
                for (int m = 0; m < 4; ++m)
#pragma unroll
                    for (int n = 0; n < 2; ++n) acc[a][b][m][n] = (f32x4){zf_, zf_, zf_, zf_};
        cur = nxt; cA = nA; cB = nB; ++ui;
        if constexpr (ALIGN_EPI) { if (wr == 1) PG8_BAR; }
    }
    PG8_WAIT_V(0);
    if constexpr (!ALIGN_EPI) { if (wr == 0) PG8_BAR; }
    PG8_BAR;
    if constexpr (Epi::AFTER_DRAIN) { E.fused(acc, cur, wr, wc, fr, fq, lds, wid, lane); S.done(cur); }
#undef PG8_SA
#undef PG8_SB
#undef PG8_STAGE
#undef PG8_LDA
#undef PG8_LDB
#undef PG8_MMA
#undef PG8_WAIT_V
#undef PG8_WAIT_L
#undef PG8_BAR
#undef PG8_SCHED
}
template <class Epi, class Sched, bool ALIGN_EPI = false, bool SP2 = false>
__device__ __forceinline__ void gemm_phase_g(PG8_LAS unsigned char* lds, const Gemm g, const Sched& S, const Epi& E) {
    int tid_ = mk_tid(); asm volatile("" : "+v"(tid_));
    const int tid = tid_, wid = __builtin_amdgcn_readfirstlane(tid >> 6), lane = tid & 63, wr = wid >> 2, wc = wid & 3, fr = lane & 15, fq = lane >> 4;
    const int K = g.K, nt = K / BK;
    unsigned voffB[2]; int RA[2], CA[2];
#pragma unroll
    for (int i = 0; i < 2; ++i) { int R, C; stage_rc(tid * 16 + i * 8192, R, C); const int Rb = Epi::PERM ? ((R & ~31) + perm32(R & 31)) : R;
        RA[i] = R; CA[i] = C; voffB[i] = (unsigned)(Rb * K + C) * 2u; }
    unsigned va0[2], va1[2], vn0[2], vn1[2];
#define PG8_AOFF(u, d0, d1) do { _Pragma("unroll") for (int _i = 0; _i < 2; ++_i) { d0[_i] = (unsigned)(S.arow(u, RA[_i]) * K + CA[_i]) * 2u; d1[_i] = (unsigned)(S.arow(u, HALF + RA[_i]) * K + CA[_i]) * 2u; } } while (0)
    const size_t kstep = (size_t)(BK * 2);
    const size_t hstep = (size_t)HALF * K * 2;
    const size_t tstep = 2 * hstep;
    const unsigned ldsw = (unsigned)wid * 1024u;
    const int aoff = lds_byte(wr * 64 + fr, fq * 8), boff = lds_byte(wc * 32 + fr, fq * 8);
#define PG8_SA(b, h) (((b) * 2 + (h)) * HTB)
#define PG8_SB(b, h) ((4 + (b) * 2 + (h)) * HTB)
#define PG8_STAGE(bufoff, gbase, voff) do { _Pragma("unroll") for (int _i = 0; _i < 2; ++_i) \
        __builtin_amdgcn_global_load_lds((const unsigned*)((const char*)(gbase) + (voff)[_i]), (PG8_LAS unsigned*)(lds + (bufoff) + ldsw + _i * 8192), 16, 0, 0); } while (0)
#define PG8_LDA(dst, b, h) do { _Pragma("unroll") for (int m = 0; m < 4; ++m) _Pragma("unroll") for (int k = 0; k < 2; ++k) dst[m][k] = *(const PG8_LAS bf16x8*)(lds + PG8_SA(b, h) + aoff + m * 2048 + k * 1024); } while (0)
#define PG8_LDB(dst, b, h) do { _Pragma("unroll") for (int n = 0; n < 2; ++n) _Pragma("unroll") for (int k = 0; k < 2; ++k) dst[n][k] = *(const PG8_LAS bf16x8*)(lds + PG8_SB(b, h) + boff + n * 2048 + k * 1024); } while (0)
#define PG8_MMA(ai, bj, At, Bt) do { __builtin_amdgcn_s_setprio(1); _Pragma("unroll") for (int m = 0; m < 4; ++m) _Pragma("unroll") for (int n = 0; n < 2; ++n) _Pragma("unroll") for (int k = 0; k < 2; ++k) \
        acc[ai][bj][m][n] = __builtin_amdgcn_mfma_f32_16x16x32_bf16(Bt[n][k], At[m][k], acc[ai][bj][m][n], 0, 0, 0); __builtin_amdgcn_s_setprio(0); } while (0)
#define PG8_WAIT_V(n) asm volatile("s_waitcnt vmcnt(" #n ")" ::: "memory")
#define PG8_WAIT_L(n) asm volatile("s_waitcnt lgkmcnt(" #n ")" ::: "memory")
#define PG8_BAR __builtin_amdgcn_s_barrier()
#define PG8_SCHED __builtin_amdgcn_sched_barrier(0)
    Unit cur, nxt; int ui = 0;
    float zf_ = 0.f; asm volatile("" : "+v"(zf_));
    if (!S.next(0, cur)) return;
    f32x4 acc[2][2][4][2];
#pragma unroll
    for (int a = 0; a < 2; ++a)
#pragma unroll
        for (int b = 0; b < 2; ++b)
#pragma unroll
            for (int m = 0; m < 4; ++m)
#pragma unroll
                for (int n = 0; n < 2; ++n) acc[a][b][m][n] = (f32x4){zf_, zf_, zf_, zf_};
    bf16x8 At[4][2], B0[2][2], B1[2][2];
    const char* cA = (const char*)g.A; const char* cB = (const char*)g.Bt + (size_t)cur.pn * tstep;
    S.a_ready(cur);
    PG8_AOFF(cur, va0, va1);
    if constexpr (SP2) {
        PG8_STAGE(PG8_SB(0, 0), cB, voffB); PG8_STAGE(PG8_SB(0, 1), cB + hstep, voffB); PG8_STAGE(PG8_SA(0, 0), cA, va0); PG8_STAGE(PG8_SA(0, 1), cA, va1);
        if (wr == 1) PG8_BAR;
        PG8_WAIT_V(2); PG8_BAR;
        PG8_STAGE(PG8_SB(1, 0), cB + kstep, voffB); PG8_STAGE(PG8_SA(1, 0), cA + kstep, va0); PG8_STAGE(PG8_SB(1, 1), cB + hstep + kstep, voffB);
        PG8_WAIT_V(6); PG8_BAR;
    } else {
        PG8_STAGE(PG8_SB(0, 0), cB, voffB); PG8_STAGE(PG8_SA(0, 0), cA, va0); PG8_STAGE(PG8_SB(0, 1), cB + hstep, voffB); PG8_STAGE(PG8_SA(0, 1), cA, va1);
        if (wr == 1) PG8_BAR;
        PG8_WAIT_V(4); PG8_BAR;
        PG8_STAGE(PG8_SB(1, 0), cB + kstep, voffB); PG8_STAGE(PG8_SA(1, 0), cA + kstep, va0); PG8_STAGE(PG8_SB(1, 1), cB + hstep + kstep, voffB);
        PG8_WAIT_V(6); PG8_BAR;
    }
    for (;;) {
        const bool has_next = S.next(ui + 1, nxt);
        if (has_next) PG8_AOFF(nxt, vn0, vn1); else { vn0[0] = va0[0]; vn0[1] = va0[1]; vn1[0] = va1[0]; vn1[1] = va1[1]; }
        const char* nA = cA; const char* nB = has_next ? (const char*)g.Bt + (size_t)nxt.pn * tstep : cB;
#pragma unroll 1
        for (int t = 0; t < nt; t += 2) {
            const bool last = (t == nt - 2);
            const char* a1 = cA + (size_t)(t + 1) * kstep;
            const char* a2 = last ? nA : cA + (size_t)(t + 2) * kstep; const char* b2 = last ? nB : cB + (size_t)(t + 2) * kstep;
            const char* a3 = a2 + kstep; const char* b3 = b2 + kstep;
            unsigned w0[2], w1[2]; w0[0] = last ? vn0[0] : va0[0]; w0[1] = last ? vn0[1] : va0[1]; w1[0] = last ? vn1[0] : va1[0]; w1[1] = last ? vn1[1] : va1[1];
            if (last && has_next) S.a_ready(nxt);
            if constexpr (SP2) {
            PG8_LDB(B0, 0, 0); PG8_LDB(B1, 0, 1); PG8_SCHED; PG8_LDA(At, 0, 0); PG8_STAGE(PG8_SA(1, 1), a1, va1);
            PG8_WAIT_V(8); PG8_WAIT_L(0); PG8_BAR; PG8_MMA(0, 0, At, B0); PG8_MMA(0, 1, At, B1); PG8_BAR; PG8_SCHED;
            PG8_LDA(At, 0, 1); PG8_STAGE(PG8_SB(0, 0), b2, voffB); PG8_STAGE(PG8_SB(0, 1), b2 + hstep, voffB); PG8_STAGE(PG8_SA(0, 0), a2, w0);
            PG8_WAIT_V(8); PG8_WAIT_L(0); PG8_BAR; PG8_MMA(1, 0, At, B0); PG8_MMA(1, 1, At, B1); PG8_BAR; PG8_SCHED;
            PG8_LDB(B0, 1, 0); PG8_LDB(B1, 1, 1); PG8_SCHED; PG8_LDA(At, 1, 0); PG8_STAGE(PG8_SA(0, 1), a2, w1);
            PG8_WAIT_V(8); PG8_WAIT_L(0); PG8_BAR; PG8_MMA(0, 0, At, B0); PG8_MMA(0, 1, At, B1); PG8_BAR; PG8_SCHED;
            PG8_LDA(At, 1, 1); PG8_STAGE(PG8_SB(1, 0), b3, voffB); PG8_STAGE(PG8_SB(1, 1), b3 + hstep, voffB); PG8_STAGE(PG8_SA(1, 0), a3, w0);
            PG8_WAIT_V(8); PG8_WAIT_L(0); PG8_BAR; PG8_MMA(1, 0, At, B0); PG8_MMA(1, 1, At, B1); PG8_BAR; PG8_SCHED;
            } else {
            PG8_LDB(B0, 0, 0); PG8_SCHED; PG8_LDA(At, 0, 0); PG8_STAGE(PG8_SA(1, 1), a1, va1);
            PG8_WAIT_L(8); PG8_BAR; PG8_WAIT_L(0); PG8_MMA(0, 0, At, B0); PG8_BAR; PG8_SCHED;
            PG8_LDB(B1, 0, 1); PG8_STAGE(PG8_SB(0, 0), b2, voffB);
            PG8_BAR; PG8_WAIT_L(0); PG8_MMA(0, 1, At, B1); PG8_BAR;
            PG8_LDA(At, 0, 1); PG8_STAGE(PG8_SA(0, 0), a2, w0);
            PG8_BAR; PG8_WAIT_L(0); PG8_MMA(1, 0, At, B0); PG8_BAR; PG8_SCHED;
            PG8_STAGE(PG8_SB(0, 1), b2 + hstep, voffB);
            PG8_WAIT_V(6); PG8_BAR; PG8_MMA(1, 1, At, B1); PG8_BAR;
            PG8_LDB(B0, 1, 0); PG8_SCHED; PG8_LDA(At, 1, 0); PG8_STAGE(PG8_SA(0, 1), a2, w1);
            PG8_WAIT_L(8); PG8_BAR; PG8_WAIT_L(0); PG8_MMA(0, 0, At, B0); PG8_BAR; PG8_SCHED;
            PG8_LDB(B1, 1, 1); PG8_STAGE(PG8_SB(1, 0), b3, voffB);
            PG8_BAR; PG8_WAIT_L(0); PG8_MMA(0, 1, At, B1); PG8_BAR;
            PG8_LDA(At, 1, 1); PG8_STAGE(PG8_SA(1, 0), a3, w0);
            PG8_BAR; PG8_WAIT_L(0); PG8_MMA(1, 0, At, B0); PG8_BAR; PG8_SCHED;
            PG8_STAGE(PG8_SB(1, 1), b3 + hstep, voffB);
            PG8_WAIT_V(6); PG8_BAR; PG8_MMA(1, 1, At, B1); PG8_BAR;
            }
        }
        if constexpr (ALIGN_EPI) { if (wr == 0) PG8_BAR; }
        if constexpr (!Epi::AFTER_DRAIN) { E(acc, cur, wr, wc, fr, fq); S.done(cur); }
        if (!has_next) break;
#pragma unroll
        for (int a = 0; a < 2; ++a)
#pragma unroll
            for (int b = 0; b < 2; ++b)
#pragma unroll
                for (int m = 0; m < 4; ++m)
#pragma unroll
                    for (int n = 0; n < 2; ++n) acc[a][b][m][n] = (f32x4){zf_, zf_, zf_, zf_};
        cur = nxt; cA = nA; cB = nB; ++ui; va0[0] = vn0[0]; va0[1] = vn0[1]; va1[0] = vn1[0]; va1[1] = vn1[1];
        if constexpr (ALIGN_EPI) { if (wr == 1) PG8_BAR; }
    }
    PG8_WAIT_V(0);
    if constexpr (!ALIGN_EPI) { if (wr == 0) PG8_BAR; }
    PG8_BAR;
    if constexpr (Epi::AFTER_DRAIN) { E.fused(acc, cur, wr, wc, fr, fq, lds, wid, lane); S.done(cur); }
#undef PG8_AOFF
#undef PG8_SA
#undef PG8_SB
#undef PG8_STAGE
#undef PG8_LDA
#undef PG8_LDB
#undef PG8_MMA
#undef PG8_WAIT_V
#undef PG8_WAIT_L
#undef PG8_BAR
#undef PG8_SCHED
}
}
constexpr int NWAVES = 8, NTHR = 512;
constexpr int T = 32768, SEQ = 16384, DM = 2048, INW = 3904, NLAYER = 2, NEXP = 64;
constexpr float LN_EPS = 1e-5f, ALPHA = 1.41421356237f;
constexpr float QSCALE = 0.07216878364870322f * 1.4426950408889634f;
constexpr size_t MiB = 1u << 20;
constexpr size_t WS_CTL = 0, CTL_ZERO_BYTES = 1 * MiB;
constexpr int CW_TMO = 0, CW_BAR = 4096, CW_CNT = 8192, CNT_STRIDE = 32;
constexpr size_t WS_TW = 1 * MiB;
constexpr size_t WS_TWP = 1 * MiB + 256 * 1024;
constexpr size_t WS_ROPE = 2 * MiB;
constexpr size_t WS_WR = 6 * MiB;
constexpr size_t WS_RQ = 7 * MiB, WS_RKV = 7 * MiB + 512 * 1024;
constexpr size_t WS_ROUTE = 8 * MiB;
constexpr size_t WS_GATES = 9 * MiB;
constexpr size_t WS_ROWINFO = 10 * MiB, WS_SLOTW = 11 * MiB;
constexpr size_t WS_PART = 1600 * MiB;
constexpr size_t WS_XB = 16 * MiB;
constexpr size_t WS_R1 = 144 * MiB;
constexpr size_t WS_U = WS_R1, WS_QKV = WS_R1 + 96 * MiB, WS_CQ = WS_R1 + 192 * MiB, WS_CKV = WS_R1 + 224 * MiB, WS_KR = WS_R1 + 240 * MiB;
constexpr size_t WS_H1 = WS_R1;
constexpr size_t WS_R2 = 400 * MiB;
constexpr size_t WS_UT = WS_R2, WS_QN = WS_R2 + 96 * MiB, WS_QR = WS_R2 + 160 * MiB, WS_KN = WS_R2 + 192 * MiB, WS_V = WS_R2 + 256 * MiB, WS_KROT = WS_R2 + 320 * MiB;
constexpr size_t WS_XM = WS_R2;
constexpr size_t WS_TOK = 12 * MiB;
constexpr size_t WS_R3 = 724 * MiB;
constexpr size_t WS_Y = WS_R3, WS_YT = WS_R3 + 96 * MiB, WS_MIX = WS_R3 + 128 * MiB, WS_FF = WS_R3, WS_KT = WS_R3;
constexpr size_t WS_HH = 980 * MiB;
constexpr size_t WS_WIN = 1060 * MiB, WS_WUQ = 1076 * MiB, WS_WUKV = 1078 * MiB, WS_WOUT = 1080 * MiB, WS_WGU = 1088 * MiB, WS_WDN = 1344 * MiB;
constexpr size_t WS_KF = 1472 * MiB;
constexpr size_t WS_TABE = 1608 * MiB;
constexpr size_t WS_END = 1640 * MiB;
constexpr int LDS_MAIN = 157696;
constexpr int LC_BAR = LDS_MAIN;
constexpr int LC_TP = LDS_MAIN + 64, LC_CNT = LC_TP + 65 * 4 + 60, LC_TILEE = LC_CNT + 64 * 4;
constexpr int LC_TWS = 139264;
static_assert(LC_WID == LDS_MAIN + 2048, "LC_WID");
constexpr int LDS_BYTES = LDS_MAIN + 4096;
static_assert(LDS_BYTES <= 163840, "LDS");
static_assert(LC_TILEE + 320 * 4 <= LDS_BYTES, "LDS map");

#define GAS __attribute__((address_space(1)))
typedef unsigned short bf16;
typedef float f32x4 __attribute__((ext_vector_type(4)));
typedef float f32x2 __attribute__((ext_vector_type(2)));
typedef unsigned u32x4 __attribute__((ext_vector_type(4)));
typedef unsigned u32x2 __attribute__((ext_vector_type(2)));
typedef int i32x4 __attribute__((ext_vector_type(4)));
#define LDS_WAIT() asm volatile("s_waitcnt lgkmcnt(0)" ::: "memory")
#define VM_WAIT() asm volatile("s_waitcnt vmcnt(0)" ::: "memory")
__device__ __forceinline__ unsigned pk2(float lo, float hi) { return pg8::cvt_pk_bf16(lo, hi); }
__device__ __forceinline__ float bflo(unsigned w) { return __uint_as_float(w << 16); }
__device__ __forceinline__ float bfhi(unsigned w) { return __uint_as_float(w & 0xffff0000u); }
__device__ __forceinline__ float wave_sum(float v, int lane) {
#pragma unroll
    for (int o = 1; o < 64; o <<= 1) v += shx(v, o, lane);
    return v;
}
__device__ __forceinline__ void row_stats(const f32x2* part, int row, int lane, float& mean, float& rstd) {
    f32x2 p = {0.f, 0.f}; if (lane < 32) p = part[(size_t)row * 32 + lane];
    const float s = wave_sum(p.x, lane), q = wave_sum(p.y, lane); mean = s * (1.0f / 2048.0f); const float var = q * (1.0f / 2048.0f) - mean * mean; rstd = 1.0f / sqrtf(var + 1e-5f);
}
struct Args { const float* in[28]; float* out; unsigned char* ws; int ph_lo, ph_hi; };
struct Frame { LAS unsigned char* lds; int tid, lane, wave, G, bid, gw, NGW; };
enum { I_X = 0, I_WIN, I_CONVW, I_CONVB, I_HW1, I_HB1, I_HF1, I_HW2, I_HB2, I_HF2, I_HW3, I_HD, I_RPB, I_QG, I_WUQ, I_KVG, I_WUKV, I_GRPG, I_WOUT, I_LN1G, I_LN1B, I_RW, I_RB, I_EG, I_EU, I_ED, I_LN2G, I_LN2B };
#define XB_TMO      128
#define XB_XCNT(j)  (256  + 64 * (j))
#define XB_XSUB(j)  (1280 + 64 * (j))
#define XB_XGEN(j)  (2304 + 64 * (j))
#define XB_TOP      3328
#define XB_TOPGEN   3392
#define XCD_BAR_WORDS 3456
#define XB_SPIN_CAP (1u << 18)

__device__ __forceinline__ unsigned xb_ld(unsigned* p)              { return __hip_atomic_load(p, __ATOMIC_RELAXED, __HIP_MEMORY_SCOPE_AGENT); }
__device__ __forceinline__ unsigned xb_add(unsigned* p, unsigned v) { return __hip_atomic_fetch_add(p, v, __ATOMIC_RELAXED, __HIP_MEMORY_SCOPE_AGENT); }
__device__ __forceinline__ unsigned xb_xcc_id() { return (unsigned)__builtin_amdgcn_s_getreg((3 << 11) | 20) & 0xFu; }
#define XB_SPIN(cond, bar) do { unsigned _sp = 0; while (cond) { __builtin_amdgcn_s_sleep(1); \
    if ((++_sp & 255u) == 0u) { if (xb_ld(&(bar)[XB_TMO])) break; if (_sp > XB_SPIN_CAP) { atomicAdd(&(bar)[XB_TMO], 1u); break; } } } } while (0)

struct XcdBarrier {
    unsigned* bar; unsigned x;
    volatile LAS unsigned* st;
};

__device__ __forceinline__ XcdBarrier xcd_barrier_post(unsigned* bar, volatile LAS unsigned* st) {
    XcdBarrier b; b.bar = bar; b.x = xb_xcc_id(); b.st = st;
    if (mk_tid() == 0) (void)xb_add(&bar[XB_XCNT(b.x)], 1u);
    return b;
}
__device__ __forceinline__ void xcd_barrier_complete(unsigned* bar, unsigned x, unsigned& nloc, unsigned& nx) {
    const unsigned G = gridDim.x * gridDim.y * gridDim.z;
    unsigned sum, cnt, mine, sp = 0u;
    for (;;) {
        sum = 0u; cnt = 0u; mine = 0u;
#pragma unroll
        for (unsigned j = 0; j < 16; ++j) { const unsigned c = xb_ld(&bar[XB_XCNT(j)]); sum += c; cnt += (c > 0u) ? 1u : 0u; mine = (j == x) ? c : mine; }
        if (sum == G) break;
        __builtin_amdgcn_s_sleep(1);
        if ((++sp & 255u) == 0u) { if (xb_ld(&bar[XB_TMO])) break; if (sp > XB_SPIN_CAP) { atomicAdd(&bar[XB_TMO], 1u); break; } }
    }
    nloc = mine > 0u ? mine : 1u; nx = cnt > 0u ? cnt : 1u;
}

__device__ __forceinline__ void xcd_barrier(const XcdBarrier& b) {
    asm volatile("s_waitcnt vmcnt(0)" ::: "memory");
    __syncthreads();
    if (mk_tid() == 0) {
        unsigned* bar = b.bar;
        __builtin_amdgcn_s_waitcnt(0);
        unsigned nloc = b.st[0], nx = b.st[1];
        if (nloc == 0u) { xcd_barrier_complete(bar, b.x, nloc, nx); b.st[0] = nloc; b.st[1] = nx; }
        const unsigned old = xb_add(&bar[XB_XSUB(b.x)], 1u);
        const unsigned gen = old / nloc;
        if (old + 1u == (gen + 1u) * nloc) {
            __builtin_amdgcn_fence(__ATOMIC_RELEASE, "agent");
            asm volatile("s_waitcnt vmcnt(0)" ::: "memory");
            const unsigned og = xb_add(&bar[XB_TOP], 1u);
            const unsigned tg = og / nx;
            if (og + 1u == (tg + 1u) * nx) xb_add(&bar[XB_TOPGEN], 1u);
            else XB_SPIN(xb_ld(&bar[XB_TOPGEN]) == tg, bar);
            __builtin_amdgcn_fence(__ATOMIC_ACQUIRE, "agent");
            xb_add(&bar[XB_XGEN(b.x)], 1u);
            asm volatile("s_waitcnt vmcnt(0)" ::: "memory");
        } else {
            XB_SPIN(xb_ld(&bar[XB_XGEN(b.x)]) == gen, bar);
            __builtin_amdgcn_fence(__ATOMIC_ACQUIRE, "agent");
            asm volatile("s_waitcnt vmcnt(0)" ::: "memory");
        }
    }
    __syncthreads();
}
__device__ __forceinline__ void transpose_item(const float* srcA, const float* srcB, int ld_src, bf16* dst, int ld_dst, const float* scale, LAS float* scr, int lane) {
    f32x2 v[32]; const int n2 = lane & 31; const float* sp = (n2 < 16 ? srcA + 2 * n2 : srcB + 2 * (n2 - 16)) + (size_t)(lane >> 5) * ld_src;
#pragma unroll
    for (int i = 0; i < 32; ++i) v[i] = *(const f32x2*)(sp + (size_t)(2 * i) * ld_src);
    if (scale) {
#pragma unroll
        for (int i = 0; i < 32; ++i) { const float s = scale[2 * i + (lane >> 5)]; v[i] = v[i] * s; }
    }
#pragma unroll
    for (int i = 0; i < 32; ++i) { const int kk = 2 * i + (lane >> 5); scr[kk * 65 + 2 * n2] = v[i].x; scr[kk * 65 + 2 * n2 + 1] = v[i].y; }
    LDS_WAIT(); asm volatile("" ::: "memory");
    const int c = lane & 7;
#pragma unroll
    for (int j = 0; j < 8; ++j) { const int n = (lane >> 3) + 8 * j; const LAS float* s = scr + (8 * c) * 65 + n;
        u32x4 o; o.x = pk2(s[0 * 65], s[1 * 65]); o.y = pk2(s[2 * 65], s[3 * 65]); o.z = pk2(s[4 * 65], s[5 * 65]); o.w = pk2(s[6 * 65], s[7 * 65]);
        *(u32x4*)(dst + (size_t)n * ld_dst + 8 * c) = o; }
    LDS_WAIT(); asm volatile("" ::: "memory");
}
__device__ __forceinline__ void split8(const float (&x)[8], u32x4& h, u32x4& lo) {
    h.x = pk2(x[0], x[1]); h.y = pk2(x[2], x[3]); h.z = pk2(x[4], x[5]); h.w = pk2(x[6], x[7]);
    lo.x = pk2(x[0] - bflo(h.x), x[1] - bfhi(h.x)); lo.y = pk2(x[2] - bflo(h.y), x[3] - bfhi(h.y)); lo.z = pk2(x[4] - bflo(h.z), x[5] - bfhi(h.z)); lo.w = pk2(x[6] - bflo(h.w), x[7] - bfhi(h.w));
}
__device__ __forceinline__ void hyena_ktime_tile(const Args& a, int l, Frame& F, int tile) {
    typedef short bf16x8_t __attribute__((ext_vector_type(8)));
    typedef float f32x16_t __attribute__((ext_vector_type(16)));
    LAS float* featS = (LAS float*)F.lds;
    LAS float* h1s = featS + 64 * 33;
    LAS float* h2s = h1s + 64 * 65 + 3;
    LAS float* w1s = (LAS float*)F.lds + 6276 + 64 * 68;
    LAS float* w2s = w1s + 33 * 64;
    h2s = (LAS float*)F.lds + 6276;
    const float* w1 = a.in[I_HW1] + l * 33 * 64; const float* b1 = a.in[I_HB1] + l * 64; const float* f1 = a.in[I_HF1] + l * 64;
    const float* w2 = a.in[I_HW2] + l * 64 * 64; const float* b2 = a.in[I_HB2] + l * 64; const float* f2 = a.in[I_HF2] + l * 64;
    const float* w3 = a.in[I_HW3] + (size_t)l * 64 * 2048;
    float* KT = (float*)(a.ws + WS_KT);
    const int t0 = tile * 64, tid = F.tid, lane = F.lane, wave = F.wave;
    for (int i = tid; i < 33 * 64; i += NTHR) w1s[i] = w1[i];
    for (int i = tid; i < 64 * 64; i += NTHR) w2s[i] = w2[i];
    { const int t = tid >> 3, bb = (tid & 7) * 2; const float tn = (float)(t0 + t) / (float)SEQ;
      if ((tid & 7) == 0) featS[t * 33] = tn;
#pragma unroll
      for (int i = 0; i < 2; ++i) { const int b = bb + i; const float band = 1e-4f + (15.0f - 1e-4f) * ((float)b / 15.0f); const float ang = (6.283185307179586f * tn) * band;
          featS[t * 33 + 1 + b] = cosf(ang); featS[t * 33 + 17 + b] = -sinf(ang); } }
    __syncthreads();
    { const int t = tid >> 3, j0 = (tid & 7) * 8; float z[8];
#pragma unroll
      for (int j = 0; j < 8; ++j) z[j] = b1[j0 + j];
#pragma unroll 3
      for (int f = 0; f < 33; ++f) { const float x = featS[t * 33 + f]; const f32x4 wa = *(const LAS f32x4*)(w1s + f * 64 + j0), wb = *(const LAS f32x4*)(w1s + f * 64 + j0 + 4);
          z[0] += x * wa[0]; z[1] += x * wa[1]; z[2] += x * wa[2]; z[3] += x * wa[3]; z[4] += x * wb[0]; z[5] += x * wb[1]; z[6] += x * wb[2]; z[7] += x * wb[3]; }
#pragma unroll
      for (int j = 0; j < 8; ++j) h1s[t * 65 + j0 + j] = sinf(f1[j0 + j] * z[j]); }
    __syncthreads();
    { const int t = tid >> 3, j0 = (tid & 7) * 8; float z[8];
#pragma unroll
      for (int j = 0; j < 8; ++j) z[j] = b2[j0 + j];
#pragma unroll 4
      for (int f = 0; f < 64; ++f) { const float x = h1s[t * 65 + f]; const f32x4 wa = *(const LAS f32x4*)(w2s + f * 64 + j0), wb = *(const LAS f32x4*)(w2s + f * 64 + j0 + 4);
          z[0] += x * wa[0]; z[1] += x * wa[1]; z[2] += x * wa[2]; z[3] += x * wa[3]; z[4] += x * wb[0]; z[5] += x * wb[1]; z[6] += x * wb[2]; z[7] += x * wb[3]; }
#pragma unroll
      for (int j = 0; j < 8; ++j) h2s[t * 68 + j0 + j] = sinf(f2[j0 + j] * z[j]); }
    __syncthreads();
    const int r = lane & 31, h = lane >> 5;
    u32x4 ah[2][4], al[2][4];
#pragma unroll
    for (int rb = 0; rb < 2; ++rb)
#pragma unroll
        for (int ks = 0; ks < 4; ++ks) { const LAS float* p = h2s + (32 * rb + r) * 68 + 16 * ks + 8 * h; const f32x4 x0 = *(const LAS f32x4*)p, x1 = *(const LAS f32x4*)(p + 4);
            const float x[8] = {x0[0], x0[1], x0[2], x0[3], x1[0], x1[1], x1[2], x1[3]}; split8(x, ah[rb][ks], al[rb][ks]); }
    const float dA = -3.0701134573253943f, dB = -15.350567286626973f;
#pragma unroll 1
    for (int cb = 0; cb < 8; ++cb) { const int c = wave * 256 + cb * 32 + r;
        float wv[4][8];
#pragma unroll
        for (int ks = 0; ks < 4; ++ks)
#pragma unroll
            for (int j = 0; j < 8; ++j) wv[ks][j] = w3[(size_t)(16 * ks + 8 * h + j) * 2048 + c];
        f32x16_t acc0 = {}, acc1 = {};
#pragma unroll
        for (int ks = 0; ks < 4; ++ks) { u32x4 bh, bl; split8(wv[ks], bh, bl);
            const bf16x8_t Bh = __builtin_bit_cast(bf16x8_t, bh), Bl = __builtin_bit_cast(bf16x8_t, bl);
            acc0 = __builtin_amdgcn_mfma_f32_32x32x16_bf16(__builtin_bit_cast(bf16x8_t, al[0][ks]), Bh, acc0, 0, 0, 0);
            acc0 = __builtin_amdgcn_mfma_f32_32x32x16_bf16(__builtin_bit_cast(bf16x8_t, ah[0][ks]), Bl, acc0, 0, 0, 0);
            acc0 = __builtin_amdgcn_mfma_f32_32x32x16_bf16(__builtin_bit_cast(bf16x8_t, ah[0][ks]), Bh, acc0, 0, 0, 0);
            acc1 = __builtin_amdgcn_mfma_f32_32x32x16_bf16(__builtin_bit_cast(bf16x8_t, al[1][ks]), Bh, acc1, 0, 0, 0);
            acc1 = __builtin_amdgcn_mfma_f32_32x32x16_bf16(__builtin_bit_cast(bf16x8_t, ah[1][ks]), Bl, acc1, 0, 0, 0);
            acc1 = __builtin_amdgcn_mfma_f32_32x32x16_bf16(__builtin_bit_cast(bf16x8_t, ah[1][ks]), Bh, acc1, 0, 0, 0); }
        const float delta = fabsf(dA + (dB - dA) * ((float)(c & 511) / 511.0f)); float* dst = KT + (size_t)c * SEQ + t0 + 4 * h;
#pragma unroll
        for (int g = 0; g < 4; ++g) { f32x4 o0, o1;
#pragma unroll
            for (int j = 0; j < 4; ++j) { const float tn0 = (float)(t0 + 8 * g + 4 * h + j) / (float)SEQ, tn1 = (float)(t0 + 32 + 8 * g + 4 * h + j) / (float)SEQ;
                o0[j] = acc0[4 * g + j] * expf(-tn0 * delta); o1[j] = acc1[4 * g + j] * expf(-tn1 * delta); }
            *(f32x4*)(dst + 8 * g) = o0; *(f32x4*)(dst + 32 + 8 * g) = o1; }
        asm volatile("" ::: "memory");
    }
    __syncthreads();
}
__device__ __forceinline__ void ph_prologue(const Args& a, int l, Frame& F) {
    unsigned char* ws = a.ws;
#ifndef NO_KT
#ifndef KT_REP
#define KT_REP 1
#endif
    for (int rep_ = 0; rep_ < KT_REP; ++rep_)
    for (int tile = F.bid; tile < SEQ / 64; tile += F.G) hyena_ktime_tile(a, l, F, tile);
#endif
    LAS float* scr = (LAS float*)(F.lds + F.wave * 16640);
    constexpr int SA = 32 * 61, SB = 8 * 24, SC = 4 * 32, SD = 32 * 32, SE = 64 * 32 * 16, SF = 64 * 8 * 32, NITEMS = SA + SB + SC + SD + SE + SF;
    const float* w_in = a.in[I_WIN] + (size_t)l * DM * INW; const float* w_uq = a.in[I_WUQ] + (size_t)l * 512 * 1536; const float* w_ukv = a.in[I_WUKV] + (size_t)l * 256 * 2048;
    const float* w_out = a.in[I_WOUT] + (size_t)l * 2048 * 2048; const float* eg = a.in[I_EG] + (size_t)l * NEXP * 2048 * 512; const float* eu = a.in[I_EU] + (size_t)l * NEXP * 2048 * 512;
    const float* ed = a.in[I_ED] + (size_t)l * NEXP * 512 * 2048;
    bf16* WIN = (bf16*)(ws + WS_WIN); bf16* WUQ = (bf16*)(ws + WS_WUQ); bf16* WUKV = (bf16*)(ws + WS_WUKV); bf16* WOUT = (bf16*)(ws + WS_WOUT); bf16* WGU = (bf16*)(ws + WS_WGU); bf16* WDN = (bf16*)(ws + WS_WDN);
#ifndef NO_TR
#ifndef PRO_REP
#define PRO_REP 1
#endif
    for (int rep_ = 0; rep_ < PRO_REP; ++rep_)
    for (int it = F.gw; it < NITEMS; it += F.NGW) {
        int r = it; const float* srcA; const float* srcB; const float* scl = nullptr; bf16* dst; int lds_, ldd;
        if (r < SA) { const int kb = r / 61, nb = r % 61, k0 = 64 * kb, n0 = 64 * nb; srcA = w_in + (size_t)k0 * INW + n0; srcB = srcA + 32; lds_ = INW; dst = WIN + (size_t)n0 * 2048 + k0; ldd = 2048; }
        else if ((r -= SA) < SB) { const int kb = r / 24, nb = r % 24, k0 = 64 * kb, n0 = 64 * nb; int col[2];
#pragma unroll
            for (int hf = 0; hf < 2; ++hf) { const int nn = n0 + 32 * hf;
                if (nn < 1024) col[hf] = (nn >> 7) * 192 + (nn & 127);
                else { const int w = nn - 1024, tile = w >> 8, ww = w & 255, half = ww >> 7, hh = (ww & 127) >> 5; col[hf] = (tile * 4 + hh) * 192 + 128 + half * 32; } }
            srcA = w_uq + (size_t)k0 * 1536 + col[0]; srcB = w_uq + (size_t)k0 * 1536 + col[1]; lds_ = 1536; dst = WUQ + (size_t)n0 * 512 + k0; ldd = 512; scl = a.in[I_QG] + l * 512 + k0; }
        else if ((r -= SB) < SC) { const int kb = r / 32, nb = r % 32, k0 = 64 * kb, n0 = 64 * nb; const int col = n0 < 1024 ? (n0 >> 7) * 256 + (n0 & 127) : ((n0 - 1024) >> 7) * 256 + 128 + ((n0 - 1024) & 127);
            srcA = w_ukv + (size_t)k0 * 2048 + col; srcB = srcA + 32; lds_ = 2048; dst = WUKV + (size_t)n0 * 256 + k0; ldd = 256; scl = a.in[I_KVG] + l * 256 + k0; }
        else if ((r -= SC) < SD) { const int kb = r / 32, nb = r % 32, k0 = 64 * kb, n0 = 64 * nb; srcA = w_out + (size_t)k0 * 2048 + n0; srcB = srcA + 32; lds_ = 2048; dst = WOUT + (size_t)n0 * 2048 + k0; ldd = 2048; scl = a.in[I_GRPG] + l * 2048 + k0; }
        else if ((r -= SD) < SE) { const int e = r >> 9, rr = r & 511, kb = rr >> 4, nb = rr & 15, k0 = 64 * kb, n0 = 64 * nb, tile = n0 >> 8, ww = n0 & 255;
            srcA = (ww < 128 ? eg : eu) + (size_t)e * 2048 * 512 + (size_t)k0 * 512 + tile * 128 + (ww & 127); srcB = srcA + 32; lds_ = 512; dst = WGU + ((size_t)e * 1024 + n0) * 2048 + k0; ldd = 2048; }
        else { r -= SE; const int e = r >> 8, rr = r & 255, kb = rr >> 5, nb = rr & 31, k0 = 64 * kb, n0 = 64 * nb;
            srcA = ed + (size_t)e * 512 * 2048 + (size_t)k0 * 2048 + n0; srcB = srcA + 32; lds_ = 2048; dst = WDN + ((size_t)e * 2048 + n0) * 512 + k0; ldd = 512; }
        transpose_item(srcA, srcB, lds_, dst, ldd, scl, scr, F.lane);
    }
#endif
    { u32x4* z = (u32x4*)(WIN + (size_t)INW * 2048); unsigned z0 = 0u; asm volatile("" : "+v"(z0)); const u32x4 zero = {z0, z0, z0, z0};
      for (int i = F.bid * NTHR + F.tid; i < 192 * 2048 / 8; i += F.G * NTHR) z[i] = zero; }
#ifndef NO_MISC
    if (l == 0) {
        { const f32x4* x4 = (const f32x4*)a.in[I_X]; u32x4* o = (u32x4*)(ws + WS_XB);
          for (size_t i = (size_t)F.bid * NTHR + F.tid; i < (size_t)T * DM / 8; i += (size_t)F.G * NTHR) { const f32x4 p = x4[2 * i], q = x4[2 * i + 1]; o[i] = pg8::pack8(p, q); } }
        { float* cosT = (float*)(ws + WS_ROPE); float* sinT = cosT + SEQ * 32;
          for (int i = F.bid * NTHR + F.tid; i < SEQ * 32; i += F.G * NTHR) { const int pos = i >> 5, f = i & 31; const float inv = powf(10000.0f, -(float)(2 * f) / 64.0f); const float ang = (float)pos * inv; cosT[i] = cosf(ang); sinT[i] = sinf(ang); } }
        { f32x2* TW = (f32x2*)(ws + WS_TW);
          for (int i = F.bid * NTHR + F.tid; i < 16384; i += F.G * NTHR) { float s, c; sincospif((float)i / 16384.0f, &s, &c); TW[i] = (f32x2){c, -s}; } }
        { f32x2* TWP = (f32x2*)(ws + WS_TWP);
          for (int u = F.bid * NTHR + F.tid; u < 8192; u += F.G * NTHR) { const int uu = u == 0 ? 1 : u; const int jb = 31 - __clz(uu), pp_ = (2 << jb) + (uu - (1 << jb)), k = (int)(__brev((unsigned)pp_) >> 18);
              float s, c; sincospif((float)k / 16384.0f, &s, &c); TWP[u] = (f32x2){c, -s}; } }
        { u32x4* WRB = (u32x4*)(ws + WS_WR); const float* rw = a.in[I_RW];
          for (int i = F.bid * NTHR + F.tid; i < 64 * 4 * 64; i += F.G * NTHR) { const int ln = i & 63, nt = (i >> 6) & 3, ks = i >> 8, n = ln & 15, q = ln >> 4; float w[8], wl[8];
#pragma unroll
              for (int j = 0; j < 8; ++j) { w[j] = rw[(size_t)(32 * ks + 8 * q + j) * 64 + 16 * nt + n]; }
              u32x4 h; h.x = pk2(w[0], w[1]); h.y = pk2(w[2], w[3]); h.z = pk2(w[4], w[5]); h.w = pk2(w[6], w[7]);
              wl[0] = w[0] - bflo(h.x); wl[1] = w[1] - bfhi(h.x); wl[2] = w[2] - bflo(h.y); wl[3] = w[3] - bfhi(h.y); wl[4] = w[4] - bflo(h.z); wl[5] = w[5] - bfhi(h.z); wl[6] = w[6] - bflo(h.w); wl[7] = w[7] - bfhi(h.w);
              u32x4 lo; lo.x = pk2(wl[0], wl[1]); lo.y = pk2(wl[2], wl[3]); lo.z = pk2(wl[4], wl[5]); lo.w = pk2(wl[6], wl[7]);
              WRB[((ks * 4 + nt) * 2 + 0) * 64 + ln] = h; WRB[((ks * 4 + nt) * 2 + 1) * 64 + ln] = lo; } }
    }
#endif
}
__device__ __forceinline__ void ph_postproj_waveitems(const Args& a, int l, Frame& F) {
    unsigned char* ws = a.ws; const int lane = F.lane;
    { const bf16* U = (const bf16*)(ws + WS_U); bf16* UT = (bf16*)(ws + WS_UT); LAS bf16* scr = (LAS bf16*)(F.lds + F.wave * 8704);
      for (int it = F.gw; it < (T / 64) * 24; it += F.NGW) { const int tt = it / 24, cb = it % 24, row0 = tt * 64, c0 = cb * 64, b = row0 / SEQ, ts0 = row0 % SEQ;
#pragma unroll
          for (int i = 0; i < 8; ++i) { const int t = (lane >> 3) + 8 * i, pc = lane & 7; const u32x4 v = *(const u32x4*)(U + (size_t)(row0 + t) * 1536 + c0 + 8 * pc);
              LAS unsigned* d = (LAS unsigned*)(scr + t * 68 + 8 * pc); d[0] = v.x; d[1] = v.y; d[2] = v.z; d[3] = v.w; }
          LDS_WAIT(); asm volatile("" ::: "memory");
#pragma unroll
          for (int i = 0; i < 8; ++i) { const int c = (lane >> 3) + 8 * i, tp = lane & 7; unsigned short e[8];
#pragma unroll
              for (int j = 0; j < 8; ++j) e[j] = scr[(8 * tp + j) * 68 + c];
              u32x4 o; o.x = e[0] | ((unsigned)e[1] << 16); o.y = e[2] | ((unsigned)e[3] << 16); o.z = e[4] | ((unsigned)e[5] << 16); o.w = e[6] | ((unsigned)e[7] << 16);
              *(u32x4*)(UT + ((size_t)b * 1536 + c0 + c) * SEQ + ts0 + 8 * tp) = o; }
          LDS_WAIT(); asm volatile("" ::: "memory"); } }
    { const bf16* CQ = (const bf16*)(ws + WS_CQ); const bf16* CKV = (const bf16*)(ws + WS_CKV); float* RQ = (float*)(ws + WS_RQ); float* RKV = (float*)(ws + WS_RKV);
      for (int row0 = 4 * F.gw; row0 < T; row0 += 4 * F.NGW) { u32x4 v[4]; u32x2 v2[4];
#pragma unroll
          for (int i = 0; i < 4; ++i) { v[i] = *(const u32x4*)(CQ + (size_t)(row0 + i) * 512 + 8 * lane); v2[i] = *(const u32x2*)(CKV + (size_t)(row0 + i) * 256 + 4 * lane); }
          float s[4], s2[4];
#pragma unroll
          for (int i = 0; i < 4; ++i) { const unsigned w[4] = {v[i].x, v[i].y, v[i].z, v[i].w}; float acc = 0.f;
#pragma unroll
              for (int j = 0; j < 4; ++j) { const float x0 = bflo(w[j]), x1 = bfhi(w[j]); acc += x0 * x0 + x1 * x1; }
              s[i] = acc; const float y0 = bflo(v2[i].x), y1 = bfhi(v2[i].x), y2 = bflo(v2[i].y), y3 = bfhi(v2[i].y); s2[i] = y0 * y0 + y1 * y1 + y2 * y2 + y3 * y3; }
#pragma unroll
          for (int o = 1; o < 64; o <<= 1) {
#pragma unroll
              for (int i = 0; i < 4; ++i) { s[i] += shx(s[i], o, lane); s2[i] += shx(s2[i], o, lane); } }
          if (lane < 4) { const float a0 = lane == 0 ? s[0] : lane == 1 ? s[1] : lane == 2 ? s[2] : s[3], a1 = lane == 0 ? s2[0] : lane == 1 ? s2[1] : lane == 2 ? s2[2] : s2[3];
              RQ[row0 + lane] = 1.0f / sqrtf(a0 * (1.0f / 512.0f) + LN_EPS); RKV[row0 + lane] = 1.0f / sqrtf(a1 * (1.0f / 256.0f) + LN_EPS); } } }
    { const bf16* KR = (const bf16*)(ws + WS_KR); bf16* KROT = (bf16*)(ws + WS_KROT); const float* cosT = (const float*)(ws + WS_ROPE); const float* sinT = cosT + SEQ * 32;
      for (int i = F.bid * NTHR + F.tid; i < T * 4; i += F.G * NTHR) { const int row = i >> 2, d0 = (i & 3) * 8, pos = row & (SEQ - 1);
          const u32x4 a1 = *(const u32x4*)(KR + (size_t)row * 64 + d0), a2 = *(const u32x4*)(KR + (size_t)row * 64 + 32 + d0);
          const f32x4 c0 = *(const f32x4*)(cosT + pos * 32 + d0), c1 = *(const f32x4*)(cosT + pos * 32 + d0 + 4), s0 = *(const f32x4*)(sinT + pos * 32 + d0), s1 = *(const f32x4*)(sinT + pos * 32 + d0 + 4);
          const f32x4 x1a = {bflo(a1.x), bfhi(a1.x), bflo(a1.y), bfhi(a1.y)}, x1b = {bflo(a1.z), bfhi(a1.z), bflo(a1.w), bfhi(a1.w)};
          const f32x4 x2a = {bflo(a2.x), bfhi(a2.x), bflo(a2.y), bfhi(a2.y)}, x2b = {bflo(a2.z), bfhi(a2.z), bflo(a2.w), bfhi(a2.w)};
          *(u32x4*)(KROT + (size_t)row * 64 + d0) = pg8::pack8(x1a * c0 - x2a * s0, x1b * c1 - x2b * s1);
          *(u32x4*)(KROT + (size_t)row * 64 + 32 + d0) = pg8::pack8(x1a * s0 + x2a * c0, x1b * s1 + x2b * c1); } }
}
__device__ __forceinline__ float ssq8(const u32x4 v) { float s = 0.f; const unsigned w[4] = {v.x, v.y, v.z, v.w};
#pragma unroll
    for (int j = 0; j < 4; ++j) { const float x0 = bflo(w[j]), x1 = bfhi(w[j]); s += x0 * x0 + x1 * x1; } return s; }
__device__ __forceinline__ u32x4 scale8(const u32x4 v, float r) { u32x4 o; o.x = pk2(bflo(v.x) * r, bfhi(v.x) * r); o.y = pk2(bflo(v.y) * r, bfhi(v.y) * r); o.z = pk2(bflo(v.z) * r, bfhi(v.z) * r); o.w = pk2(bflo(v.w) * r, bfhi(v.w) * r); return o; }
__device__ __forceinline__ void ph_groupnorm(const Args& a, Frame& F) {
    unsigned char* ws = a.ws; const bf16* Y = (const bf16*)(ws + WS_Y); const bf16* YT = (const bf16*)(ws + WS_YT); bf16* MIX = (bf16*)(ws + WS_MIX);
    LAS bf16* hyS = (LAS bf16*)F.lds;
    for (int unit = F.bid; unit < T / 64; unit += F.G) { const int row0 = unit * 64, b = row0 / SEQ, ts0 = row0 % SEQ;
        { const int cr = F.tid >> 3, ch = F.tid & 7;
#pragma unroll
          for (int i = 0; i < 8; ++i) { const int c = cr + 64 * i; const u32x4 v = *(const u32x4*)(YT + ((size_t)b * 512 + c) * SEQ + ts0 + 8 * ch); const unsigned w[4] = {v.x, v.y, v.z, v.w};
#pragma unroll
              for (int j = 0; j < 4; ++j) { hyS[(8 * ch + 2 * j) * 520 + c] = (bf16)(w[j] & 0xffffu); hyS[(8 * ch + 2 * j + 1) * 520 + c] = (bf16)(w[j] >> 16); } } }
        __syncthreads();
        for (int i0 = 0; i0 < 8; i0 += 4) { const int lane = F.lane; u32x4 hy[4], na[4], m0[4], m1[4];
#pragma unroll
            for (int i = 0; i < 4; ++i) { const int t = F.wave * 8 + i0 + i, row = row0 + t;
                na[i] = *(const u32x4*)(Y + (size_t)row * 1536 + 8 * lane); m0[i] = *(const u32x4*)(Y + (size_t)row * 1536 + 512 + 8 * lane); m1[i] = *(const u32x4*)(Y + (size_t)row * 1536 + 1024 + 8 * lane);
                hy[i] = *(const LAS u32x4*)(hyS + t * 520 + 8 * lane); }
            float sh[4], sn[4], sm[4];
#pragma unroll
            for (int i = 0; i < 4; ++i) { sh[i] = ssq8(hy[i]); sn[i] = ssq8(na[i]); sm[i] = ssq8(m0[i]) + ssq8(m1[i]); }
#pragma unroll
            for (int o = 1; o < 64; o <<= 1) {
#pragma unroll
                for (int i = 0; i < 4; ++i) { sh[i] += shx(sh[i], o, lane); sn[i] += shx(sn[i], o, lane); sm[i] += shx(sm[i], o, lane); } }
#pragma unroll
            for (int i = 0; i < 4; ++i) { const int row = row0 + F.wave * 8 + i0 + i;
                const float rh = 1.0f / sqrtf(sh[i] * (1.0f / 512.0f) + LN_EPS), rn = 1.0f / sqrtf(sn[i] * (1.0f / 512.0f) + LN_EPS), rm = 1.0f / sqrtf(sm[i] * (1.0f / 1024.0f) + LN_EPS);
                bf16* o = MIX + (size_t)row * 2048 + 8 * lane;
                *(u32x4*)o = scale8(hy[i], rh); *(u32x4*)(o + 512) = scale8(na[i], rn); *(u32x4*)(o + 1024) = scale8(m0[i], rm); *(u32x4*)(o + 1536) = scale8(m1[i], rm); } }
        __syncthreads();
    }
}
__device__ __forceinline__ void ph_router(const Args& a, int l, Frame& F, int rep = 0) {
    unsigned char* ws = a.ws; const bf16* H1 = (const bf16*)(ws + WS_H1); const f32x2* part = (const f32x2*)(ws + WS_PART);
    const float* g1 = a.in[I_LN1G] + l * DM; const float* b1 = a.in[I_LN1B] + l * DM; const u32x4* WRB = (const u32x4*)(ws + WS_WR); const float* rb = a.in[I_RB];
    unsigned* cnt = (unsigned*)(ws + WS_CTL) + CW_CNT + 64 * (l + 2 * rep) * CNT_STRIDE; u32x2* tabE = (u32x2*)(ws + WS_TABE) + (size_t)rep * 64 * T; bf16* XM = (bf16*)(ws + WS_XM) + (size_t)rep * T * DM;
    typedef short bf16x8_t __attribute__((ext_vector_type(8)));
    LAS u32x4* Bs = (LAS u32x4*)F.lds;
    LAS float* lg = (LAS float*)(F.lds + F.wave * 4352);
    const int lane = F.lane, r = lane & 15, q = lane >> 4, tid = F.tid;
    if (tid < 64) ((LAS unsigned*)(F.lds + LC_TP))[tid] = 0u;
    LAS float* gS = (LAS float*)(F.lds + 131072); LAS float* bS = gS + DM;
    for (int i = tid; i < DM; i += NTHR) { gS[i] = g1[i]; bS[i] = b1[i]; }
    __syncthreads();
    for (int unit = F.bid; unit < T / 128; unit += F.G) { const int row0 = unit * 128 + F.wave * 16;
        float s = 0.f, sq = 0.f;
#pragma unroll
        for (int i = 0; i < 8; ++i) { const f32x2 pp = part[(size_t)(row0 + r) * 32 + 8 * q + i]; s += pp.x; sq += pp.y; }
        s += shx(s, 16, lane); s += shx(s, 32, lane); sq += shx(sq, 16, lane); sq += shx(sq, 32, lane);
        const float mean = s * (1.0f / DM), var = sq * (1.0f / DM) - mean * mean, rstd = 1.0f / sqrtf(var + LN_EPS);
        f32x4 acc[4];
#pragma unroll
        for (int nt = 0; nt < 4; ++nt) acc[nt] = (f32x4){0.f, 0.f, 0.f, 0.f};
        const bf16* hrow = H1 + (size_t)(row0 + r) * DM + 8 * q;
        u32x4 st[8];
#pragma unroll
        for (int j = 0; j < 8; ++j) st[j] = WRB[tid + NTHR * j];
#pragma unroll
        for (int j = 0; j < 8; ++j) Bs[tid + NTHR * j] = st[j];
        u32x4 hv[8];
#pragma unroll
        for (int ks = 0; ks < 8; ++ks) hv[ks] = *(const u32x4*)(hrow + 32 * ks);
        __syncthreads();
#pragma unroll 1
        for (int c = 0; c < 8; ++c) { const LAS u32x4* Bc = Bs + (c & 1) * 4096; u32x4 hn[8];
            if (c + 1 < 8) {
#pragma unroll
                for (int j = 0; j < 8; ++j) st[j] = WRB[(c + 1) * 4096 + tid + NTHR * j];
#pragma unroll
                for (int ks = 0; ks < 8; ++ks) hn[ks] = *(const u32x4*)(hrow + 32 * (8 * (c + 1) + ks)); }
#pragma unroll
            for (int ks = 0; ks < 8; ++ks) { const int kk = 32 * (8 * c + ks), k = kk + 8 * q;
                const u32x4 hw_ = hv[ks]; const f32x4 h0 = {bflo(hw_.x), bfhi(hw_.x), bflo(hw_.y), bfhi(hw_.y)}, h1 = {bflo(hw_.z), bfhi(hw_.z), bflo(hw_.w), bfhi(hw_.w)};
                const f32x4 ga = *(const LAS f32x4*)(gS + k), gb = *(const LAS f32x4*)(gS + k + 4), ba = *(const LAS f32x4*)(bS + k), bb = *(const LAS f32x4*)(bS + k + 4);
                const f32x4 x0 = (h0 - mean) * rstd * ga + ba, x1 = (h1 - mean) * rstd * gb + bb;
                u32x4 xh; xh.x = pk2(x0[0], x0[1]); xh.y = pk2(x0[2], x0[3]); xh.z = pk2(x1[0], x1[1]); xh.w = pk2(x1[2], x1[3]);
                *(u32x4*)(XM + (size_t)(row0 + r) * DM + k) = xh;
                u32x4 xl; xl.x = pk2(x0[0] - bflo(xh.x), x0[1] - bfhi(xh.x)); xl.y = pk2(x0[2] - bflo(xh.y), x0[3] - bfhi(xh.y)); xl.z = pk2(x1[0] - bflo(xh.z), x1[1] - bfhi(xh.z)); xl.w = pk2(x1[2] - bflo(xh.w), x1[3] - bfhi(xh.w));
                const bf16x8_t ah = __builtin_bit_cast(bf16x8_t, xh), al = __builtin_bit_cast(bf16x8_t, xl);
#pragma unroll
                for (int nt = 0; nt < 4; ++nt) { const bf16x8_t wh = __builtin_bit_cast(bf16x8_t, Bc[((ks * 4 + nt) * 2 + 0) * 64 + lane]), wl = __builtin_bit_cast(bf16x8_t, Bc[((ks * 4 + nt) * 2 + 1) * 64 + lane]);
                    acc[nt] = __builtin_amdgcn_mfma_f32_16x16x32_bf16(al, wh, acc[nt], 0, 0, 0);
                    acc[nt] = __builtin_amdgcn_mfma_f32_16x16x32_bf16(ah, wl, acc[nt], 0, 0, 0);
                    acc[nt] = __builtin_amdgcn_mfma_f32_16x16x32_bf16(ah, wh, acc[nt], 0, 0, 0); } }
            if (c + 1 < 8) { LAS u32x4* Bn = Bs + ((c + 1) & 1) * 4096;
#pragma unroll
                for (int j = 0; j < 8; ++j) Bn[tid + NTHR * j] = st[j];
#pragma unroll
                for (int ks = 0; ks < 8; ++ks) hv[ks] = hn[ks]; }
            __syncthreads();
        }
#pragma unroll
        for (int nt = 0; nt < 4; ++nt)
#pragma unroll
            for (int v = 0; v < 4; ++v) lg[(4 * q + v) * 65 + 16 * nt + r] = acc[nt][v];
        LDS_WAIT(); asm volatile("" ::: "memory");
        LAS unsigned* lcnt = (LAS unsigned*)(F.lds + LC_TP); LAS unsigned* lbase = lcnt + 64;
        int e0 = 0, e1 = 0; unsigned r0 = 0u, r1 = 0u; float gw0 = 0.f, gw1 = 0.f;
        if (lane < 16) { const LAS float* row = lg + lane * 65; float bestv = -1e30f; int best = 0;
            for (int g = 0; g < 8; ++g) { float m1 = -1e30f, m2 = -1e30f;
#pragma unroll
                for (int i = 0; i < 8; ++i) { const float sc = 1.0f / (1.0f + expf(-row[g * 8 + i])); const float sel = sc + rb[g * 8 + i]; if (sel > m1) { m2 = m1; m1 = sel; } else if (sel > m2) m2 = sel; }
                const float gs = m1 + m2; if (gs > bestv) { bestv = gs; best = g; } }
            float m1 = -1e30f, m2 = -1e30f, s1 = 0.f, s2 = 0.f; int i1 = 0, i2 = 0;
#pragma unroll
            for (int i = 0; i < 8; ++i) { const float sc = 1.0f / (1.0f + expf(-row[best * 8 + i])); const float sel = sc + rb[best * 8 + i];
                if (sel > m1) { m2 = m1; i2 = i1; s2 = s1; m1 = sel; i1 = i; s1 = sc; } else if (sel > m2) { m2 = sel; i2 = i; s2 = sc; } }
            e0 = best * 8 + i1; e1 = best * 8 + i2; const float inv = 1.0f / (s1 + s2); gw0 = s1 * inv; gw1 = s2 * inv;
            r0 = __hip_atomic_fetch_add(lcnt + e0, 1u, __ATOMIC_RELAXED, __HIP_MEMORY_SCOPE_WORKGROUP); r1 = __hip_atomic_fetch_add(lcnt + e1, 1u, __ATOMIC_RELAXED, __HIP_MEMORY_SCOPE_WORKGROUP); }
        __syncthreads();
        if (tid < 64) { const unsigned n = lcnt[tid]; unsigned b = 0u; if (n) b = __hip_atomic_fetch_add(cnt + tid * CNT_STRIDE, n, __ATOMIC_RELAXED, __HIP_MEMORY_SCOPE_AGENT); lbase[tid] = b; }
        __syncthreads();
        if (lane < 16) { const unsigned p0 = lbase[e0] + r0, p1 = lbase[e1] + r1;
            tabE[(size_t)e0 * T + p0] = (u32x2){(unsigned)(2 * (row0 + lane)), __float_as_uint(gw0)}; tabE[(size_t)e1 * T + p1] = (u32x2){(unsigned)(2 * (row0 + lane) + 1), __float_as_uint(gw1)}; }
        __syncthreads();
        if (tid < 64) lcnt[tid] = 0u;
        __syncthreads();
    }
}
__device__ __forceinline__ void moe_tables(const Args& a, int l, Frame& F) {
    const unsigned* cnt = (const unsigned*)(a.ws + WS_CTL) + CW_CNT + 64 * l * CNT_STRIDE;
    LAS int* tp = (LAS int*)(F.lds + LC_TP); LAS int* cs = (LAS int*)(F.lds + LC_CNT); LAS int* te = (LAS int*)(F.lds + LC_TILEE);
    if (F.tid < 64) { const int c = (int)__hip_atomic_load(cnt + F.tid * CNT_STRIDE, __ATOMIC_RELAXED, __HIP_MEMORY_SCOPE_AGENT); const int nt = (c + 255) >> 8; int incl = nt;
#pragma unroll
        for (int o = 1; o < 64; o <<= 1) { const int t = shup_i(incl, o, F.lane); if (F.lane >= o) incl += t; }
        tp[F.tid] = incl - nt; cs[F.tid] = c; if (F.tid == 63) tp[64] = incl;
        for (int i = incl - nt; i < incl; ++i) te[i] = F.tid; }
    __syncthreads();
}
__device__ __forceinline__ void ph_combine(const Args& a, int l, Frame& F) {
    unsigned char* ws = a.ws; const bf16* XM = (const bf16*)(ws + WS_XM);
    const float* g2 = a.in[I_LN2G] + l * DM; const float* b2 = a.in[I_LN2B] + l * DM;
    const bf16* FF = (const bf16*)(ws + WS_FF); float* out = a.out; bf16* XB = (bf16*)(ws + WS_XB); const int lane = F.lane;
    for (int row = 2 * F.gw; row < T; row += 2 * F.NGW) {
        u32x4 xr[2][4], a0[2][4], a1[2][4];
#pragma unroll
        for (int r = 0; r < 2; ++r) { const bf16* xm = XM + (size_t)(row + r) * DM + 8 * lane; const bf16* f0 = FF + (size_t)(2 * (row + r)) * DM + 8 * lane; const bf16* f1 = f0 + DM;
#pragma unroll
            for (int j = 0; j < 4; ++j) { xr[r][j] = *(const u32x4*)(xm + 512 * j); a0[r][j] = *(const u32x4*)(f0 + 512 * j); a1[r][j] = *(const u32x4*)(f1 + 512 * j); } }
#pragma unroll
        for (int r = 0; r < 2; ++r) {
            f32x4 v[8]; float s = 0.f;
#pragma unroll
            for (int j = 0; j < 4; ++j)
#pragma unroll
                for (int hh = 0; hh < 2; ++hh) { const unsigned x0 = hh ? xr[r][j].z : xr[r][j].x, x1 = hh ? xr[r][j].w : xr[r][j].y, p0 = hh ? a0[r][j].z : a0[r][j].x, p1 = hh ? a0[r][j].w : a0[r][j].y, q0 = hh ? a1[r][j].z : a1[r][j].x, q1 = hh ? a1[r][j].w : a1[r][j].y;
                    f32x4 x; x[0] = bflo(x0) * ALPHA + (bflo(p0) + bflo(q0)); x[1] = bfhi(x0) * ALPHA + (bfhi(p0) + bfhi(q0)); x[2] = bflo(x1) * ALPHA + (bflo(p1) + bflo(q1)); x[3] = bfhi(x1) * ALPHA + (bfhi(p1) + bfhi(q1));
                    v[2 * j + hh] = x; s += (x[0] + x[1]) + (x[2] + x[3]); }
            const float mean = wave_sum(s, lane) * (1.0f / DM); float q = 0.f;
#pragma unroll
            for (int j = 0; j < 8; ++j) { v[j] = v[j] - mean; q += (v[j][0] * v[j][0] + v[j][1] * v[j][1]) + (v[j][2] * v[j][2] + v[j][3] * v[j][3]); }
            const float rstd = 1.0f / sqrtf(wave_sum(q, lane) * (1.0f / DM) + LN_EPS);
#pragma unroll
            for (int j = 0; j < 4; ++j) { const int col = 8 * lane + 512 * j; f32x4 o[2];
#pragma unroll
                for (int hh = 0; hh < 2; ++hh) { const f32x4 g = *(const f32x4*)(g2 + col + 4 * hh), bb = *(const f32x4*)(b2 + col + 4 * hh); o[hh] = v[2 * j + hh] * rstd * g + bb;
                    if (l + 1 == NLAYER) *(f32x4*)(out + (size_t)(row + r) * DM + col + 4 * hh) = o[hh]; }
                if (l + 1 < NLAYER) *(u32x4*)(XB + (size_t)(row + r) * DM + col) = pg8::pack8(o[0], o[1]); }
        }
    }
}
namespace att {
using bf16x8 = __attribute__((ext_vector_type(8))) short;
using s16x4  = __attribute__((ext_vector_type(4))) short;
using f32x16 = __attribute__((ext_vector_type(16))) float;
#define SBAR() __builtin_amdgcn_sched_barrier(0)
__device__ __forceinline__ int crow(int r, int hi) { return (r & 3) + 8 * (r >> 2) + 4 * hi; }
__device__ __forceinline__ unsigned cvtpk(float lo, float hi) { unsigned r; asm volatile("v_cvt_pk_bf16_f32 %0, %1, %2" : "=v"(r) : "v"(lo), "v"(hi)); return r; }
constexpr float THR2 = 11.5f;
__device__ __forceinline__ void partialSM(f32x16& p0, f32x16& p1, float& m_reg, float& mn, float& alpha) {
  float pmax = p0[0];
#pragma unroll
  for (int r = 1; r < 16; ++r) pmax = fmaxf(pmax, p0[r]);
#pragma unroll
  for (int r = 0; r < 16; ++r) pmax = fmaxf(pmax, p1[r]);
  { auto rr = __builtin_amdgcn_permlane32_swap(__float_as_uint(pmax), __float_as_uint(pmax), false, false);
    pmax = fmaxf(__uint_as_float(rr[0]), __uint_as_float(rr[1])); }
  if (__builtin_expect(__all(pmax - m_reg <= THR2), 1)) { mn = m_reg; alpha = 1.f; }
  else { mn = fmaxf(m_reg, pmax); alpha = __builtin_amdgcn_exp2f(m_reg - mn); m_reg = mn; }
#pragma unroll
  for (int r = 0; r < 16; ++r) p0[r] = p0[r] - mn;
#pragma unroll
  for (int r = 0; r < 16; ++r) p1[r] = p1[r] - mn;
#pragma unroll
  for (int r = 0; r < 16; ++r) p0[r] = __builtin_amdgcn_exp2f(p0[r]);
}
__device__ __forceinline__ void finishSM(f32x16& p0, f32x16& p1, float alpha, float& l_reg, bf16x8& pa0, bf16x8& pa1, bf16x8& pa2, bf16x8& pa3) {
#pragma unroll
  for (int r = 0; r < 16; ++r) p1[r] = __builtin_amdgcn_exp2f(p1[r]);
  float ps = 0;
#pragma unroll
  for (int r = 0; r < 16; ++r) ps += p0[r];
#pragma unroll
  for (int r = 0; r < 16; ++r) ps += p1[r];
  { auto rr = __builtin_amdgcn_permlane32_swap(__float_as_uint(ps), __float_as_uint(ps), false, false);
    ps = __uint_as_float(rr[0]) + __uint_as_float(rr[1]); }
  l_reg = l_reg * alpha + ps;
#define PK4(P, BASE, OUT) do { unsigned a0 = cvtpk(P[BASE + 0], P[BASE + 1]), a1 = cvtpk(P[BASE + 2], P[BASE + 3]);   \
    unsigned b0 = cvtpk(P[BASE + 4], P[BASE + 5]), b1 = cvtpk(P[BASE + 6], P[BASE + 7]);                              \
    auto r0 = __builtin_amdgcn_permlane32_swap(a0, b0, false, false); auto r1 = __builtin_amdgcn_permlane32_swap(a1, b1, false, false); \
    u32x4 w = {r0[0], r1[0], r0[1], r1[1]}; OUT = *reinterpret_cast<bf16x8*>(&w); } while (0)
  PK4(p0, 0, pa0); PK4(p0, 8, pa1); PK4(p1, 0, pa2); PK4(p1, 8, pa3);
#undef PK4
}
template <int NCB> __device__ __forceinline__ int v_st(int k, int c) { const int kk = (k & ~0xC) | ((k & 4) << 1) | ((k & 8) >> 1); return ((kk >> 3) * NCB + (c >> 5)) * 512 + ((kk & 7) * 32 + (c & 31)) * 2; }
__device__ __forceinline__ int v_rd_base(int lane) { return ((lane & 3) << 3) | (((lane >> 2) & 3) << 6) | (((lane >> 4) & 1) << 5) | (((lane >> 5) & 1) << 8); }
template <int NCB> constexpr int v_rd_off(int d0, int ks, int half) { return d0 * 512 + ks * (1024 * NCB) + half * (512 * NCB); }
template <int OFF> __device__ __forceinline__ s16x4 tr_read(int vb) {
  s16x4 r; asm volatile("ds_read_b64_tr_b16 %0, %1 offset:%2" : "=&v"(r) : "v"(vb), "i"(OFF) : "memory"); return r;
}
template <int NCB, int D0> __device__ __forceinline__ void pv_one(f32x16& od, int vb, bf16x8 pa0, bf16x8 pa1, bf16x8 pa2, bf16x8 pa3) {
  const s16x4 l0 = tr_read<v_rd_off<NCB>(D0, 0, 0)>(vb), h0 = tr_read<v_rd_off<NCB>(D0, 0, 1)>(vb), l1 = tr_read<v_rd_off<NCB>(D0, 1, 0)>(vb), h1 = tr_read<v_rd_off<NCB>(D0, 1, 1)>(vb);
  const s16x4 l2 = tr_read<v_rd_off<NCB>(D0, 2, 0)>(vb), h2 = tr_read<v_rd_off<NCB>(D0, 2, 1)>(vb), l3 = tr_read<v_rd_off<NCB>(D0, 3, 0)>(vb), h3 = tr_read<v_rd_off<NCB>(D0, 3, 1)>(vb);
  asm volatile("s_waitcnt lgkmcnt(0)" ::: "memory"); SBAR();
#define PK(L, H) (bf16x8){L[0], L[1], L[2], L[3], H[0], H[1], H[2], H[3]}
  od = __builtin_amdgcn_mfma_f32_32x32x16_bf16(pa0, PK(l0, h0), od, 0, 0, 0);
  od = __builtin_amdgcn_mfma_f32_32x32x16_bf16(pa1, PK(l1, h1), od, 0, 0, 0);
  od = __builtin_amdgcn_mfma_f32_32x32x16_bf16(pa2, PK(l2, h2), od, 0, 0, 0);
  od = __builtin_amdgcn_mfma_f32_32x32x16_bf16(pa3, PK(l3, h3), od, 0, 0, 0);
#undef PK
}
constexpr int SHM_V = 16384, SHM_KN = 16384, SHM_KR = 8192;
constexpr int OFF_V = 0, OFF_KN = 2 * SHM_V, OFF_KR = OFF_KN + 2 * SHM_KN, OFF_WS = OFF_KR + 2 * SHM_KR, OFF_QR = OFF_WS + NWAVES * 256, MLA_LDS = OFF_QR + NWAVES * 4096;
#define KNSWZ(row, colB) ((row) * 256 + ((colB) ^ (((row) & 15) << 4)))
#define KRSWZ(row, colB) ((row) * 128 + ((colB) ^ ((((row) >> 1) & 7) << 4)))
__device__ __forceinline__ void qkt_mla(f32x16& p0, f32x16& p1, const char* Kn, const char* Kr, const bf16x8* qr, const char* qrot, int r32, int hi) {
  p0 = f32x16{}; p1 = f32x16{};
  __builtin_amdgcn_s_setprio(1);
#pragma unroll
  for (int d0 = 0; d0 < 8; ++d0) { const int cb = (d0 * 16 + hi * 8) * 2;
    const bf16x8 b0 = *reinterpret_cast<const bf16x8*>(Kn + KNSWZ(r32, cb));
    const bf16x8 b1 = *reinterpret_cast<const bf16x8*>(Kn + KNSWZ(32 + r32, cb));
    p0 = __builtin_amdgcn_mfma_f32_32x32x16_bf16(b0, qr[d0], p0, 0, 0, 0);
    p1 = __builtin_amdgcn_mfma_f32_32x32x16_bf16(b1, qr[d0], p1, 0, 0, 0); }
#pragma unroll
  for (int d0 = 0; d0 < 4; ++d0) { const int cb = (d0 * 16 + hi * 8) * 2;
    const bf16x8 b0 = *reinterpret_cast<const bf16x8*>(Kr + KRSWZ(r32, cb));
    const bf16x8 b1 = *reinterpret_cast<const bf16x8*>(Kr + KRSWZ(32 + r32, cb));
    const bf16x8 q = *reinterpret_cast<const bf16x8*>(qrot + d0 * 1024);
    p0 = __builtin_amdgcn_mfma_f32_32x32x16_bf16(b0, q, p0, 0, 0, 0);
    p1 = __builtin_amdgcn_mfma_f32_32x32x16_bf16(b1, q, p1, 0, 0, 0); }
  __builtin_amdgcn_s_setprio(0);
}
__device__ __forceinline__ void qkt_mla_r(f32x16& p0, f32x16& p1, const char* Kn, const char* Kr, const bf16x8* qr, int r32, int hi) {
  p0 = f32x16{}; p1 = f32x16{};
  __builtin_amdgcn_s_setprio(1);
#pragma unroll
  for (int d0 = 0; d0 < 8; ++d0) { const int cb = (d0 * 16 + hi * 8) * 2;
    const bf16x8 b0 = *reinterpret_cast<const bf16x8*>(Kn + KNSWZ(r32, cb));
    const bf16x8 b1 = *reinterpret_cast<const bf16x8*>(Kn + KNSWZ(32 + r32, cb));
    p0 = __builtin_amdgcn_mfma_f32_32x32x16_bf16(b0, qr[d0], p0, 0, 0, 0);
    p1 = __builtin_amdgcn_mfma_f32_32x32x16_bf16(b1, qr[d0], p1, 0, 0, 0); }
#pragma unroll
  for (int d0 = 0; d0 < 4; ++d0) { const int cb = (d0 * 16 + hi * 8) * 2;
    const bf16x8 b0 = *reinterpret_cast<const bf16x8*>(Kr + KRSWZ(r32, cb));
    const bf16x8 b1 = *reinterpret_cast<const bf16x8*>(Kr + KRSWZ(32 + r32, cb));
    p0 = __builtin_amdgcn_mfma_f32_32x32x16_bf16(b0, qr[8 + d0], p0, 0, 0, 0);
    p1 = __builtin_amdgcn_mfma_f32_32x32x16_bf16(b1, qr[8 + d0], p1, 0, 0, 0); }
  __builtin_amdgcn_s_setprio(0);
}
__device__ __forceinline__ void pv_mla(f32x16* o, int vb, bf16x8 pa0, bf16x8 pa1, bf16x8 pa2, bf16x8 pa3) {
  pv_one<4, 0>(o[0], vb, pa0, pa1, pa2, pa3); pv_one<4, 1>(o[1], vb, pa0, pa1, pa2, pa3); pv_one<4, 2>(o[2], vb, pa0, pa1, pa2, pa3); pv_one<4, 3>(o[3], vb, pa0, pa1, pa2, pa3);
}
template <int SDEPTH>
__device__ __forceinline__ void mla_body(const bf16* __restrict__ Qn, const bf16* __restrict__ Qr, const bf16* __restrict__ Kn, const bf16* __restrict__ Kr, const bf16* __restrict__ Vh,
                                         bf16* __restrict__ Ob, int ldo, int seq, char* lds) {
  int tid_ = mk_tid(); asm volatile("" : "+v"(tid_));
  const int tid = tid_, wid = tid >> 6, lane = tid & 63, r32 = lane & 31, hi = lane >> 5;
  char* V_lds = lds + OFF_V; char* KN_lds = lds + OFF_KN; char* KR_lds = lds + OFF_KR;
  float* ws = (float*)(lds + OFF_WS) + wid * 64; float* li_l = ws; float* al_l = ws + 32;
  float m_reg = -1e30f, l_reg = 0; f32x16 o[4] = {}; bf16x8 qr[8];
  char* qrot = lds + OFF_QR + wid * 4096 + lane * 16;
  { const bf16* Qw = Qn + (long)(wid * 32 + r32) * 1024 + hi * 8;
#pragma unroll
    for (int d0 = 0; d0 < 8; ++d0) qr[d0] = *reinterpret_cast<const bf16x8*>(Qw + d0 * 16);
    const bf16* Qw2 = Qr + (long)(wid * 32 + r32) * 512 + hi * 8;
#pragma unroll
    for (int d0 = 0; d0 < 4; ++d0) *reinterpret_cast<bf16x8*>(qrot + d0 * 1024) = *reinterpret_cast<const bf16x8*>(Qw2 + d0 * 16); }
  const int sr = tid >> 4, sc = (tid & 15) * 8, vst0 = v_st<4>(sr, sc), vst1 = v_st<4>(32 + sr, sc);
  const int rr = tid >> 3, rc = (tid & 7) * 8;
  const int vb0 = (int)(uintptr_t)V_lds + v_rd_base(lane);
  bf16x8 s_vs0, s_vs1, s_ks0, s_ks1, s_kr;
#define SLOAD(k0) do { s_vs0 = *reinterpret_cast<const bf16x8*>(&Vh[(long)((k0) + sr) * 1024 + sc]); s_vs1 = *reinterpret_cast<const bf16x8*>(&Vh[(long)((k0) + 32 + sr) * 1024 + sc]); \
    s_ks0 = *reinterpret_cast<const bf16x8*>(&Kn[(long)((k0) + sr) * 1024 + sc]); s_ks1 = *reinterpret_cast<const bf16x8*>(&Kn[(long)((k0) + 32 + sr) * 1024 + sc]); \
    s_kr = *reinterpret_cast<const bf16x8*>(&Kr[(long)((k0) + rr) * 64 + rc]); } while (0)
#define SWRITE(b) do { *(bf16x8*)(V_lds + (b) * SHM_V + vst0) = s_vs0; *(bf16x8*)(V_lds + (b) * SHM_V + vst1) = s_vs1; const int kc = sc * 2; \
    *(bf16x8*)(KN_lds + (b) * SHM_KN + KNSWZ(sr, kc)) = s_ks0; *(bf16x8*)(KN_lds + (b) * SHM_KN + KNSWZ(32 + sr, kc)) = s_ks1; \
    *(bf16x8*)(KR_lds + (b) * SHM_KR + KRSWZ(rr, rc * 2)) = s_kr; } while (0)
  const int NT = seq / 64;
  SLOAD(0); asm volatile("s_waitcnt vmcnt(0)" ::: "memory"); SWRITE(0); __syncthreads();
#pragma unroll 1
  for (int j = 0; j < NT; ++j) {
    const int b = j & 1;
    if (j + 1 < NT) SLOAD((j + 1) * 64);
    SBAR();
    f32x16 p0, p1; float mn, alpha; bf16x8 pa0, pa1, pa2, pa3;
    qkt_mla(p0, p1, KN_lds + b * SHM_KN, KR_lds + b * SHM_KR, qr, qrot, r32, hi);
    partialSM(p0, p1, m_reg, mn, alpha);
    if (__any(alpha < 1.f)) { if (hi == 0) al_l[r32] = alpha; asm volatile("s_waitcnt lgkmcnt(0)" ::: "memory");
#pragma unroll
      for (int d = 0; d < 4; ++d)
#pragma unroll
        for (int r = 0; r < 16; ++r) o[d][r] *= al_l[crow(r, hi)]; }
    finishSM(p0, p1, alpha, l_reg, pa0, pa1, pa2, pa3); SBAR();
    pv_mla(o, vb0 + b * SHM_V, pa0, pa1, pa2, pa3);
    if (j + 1 < NT) { asm volatile("s_waitcnt vmcnt(0)" ::: "memory"); SWRITE(b ^ 1); }
    __syncthreads();
  }
  if (hi == 0) li_l[r32] = l_reg; asm volatile("s_waitcnt lgkmcnt(0)" ::: "memory");
  float rli[16];
#pragma unroll
  for (int r = 0; r < 16; ++r) rli[r] = __builtin_amdgcn_rcpf(li_l[crow(r, hi)]);
  bf16* Ow = Ob + (long)(wid * 32) * ldo;
#pragma unroll
  for (int r = 0; r < 16; ++r) { const int orow = crow(r, hi);
#pragma unroll
    for (int d0 = 0; d0 < 4; ++d0) Ow[(long)orow * ldo + d0 * 32 + r32] = (bf16)(cvtpk(o[d0][r] * rli[r], 0.f) & 0xffffu); }
  __syncthreads();
#undef SLOAD
#undef SWRITE
}
constexpr float THRZ = 64.f;
__device__ __forceinline__ void partialSM_z(f32x16& p0, f32x16& p1, float& m_reg, bool& shifted, float& alpha) {
  float pmax = p0[0];
#pragma unroll
  for (int r = 1; r < 16; ++r) pmax = fmaxf(pmax, p0[r]);
#pragma unroll
  for (int r = 0; r < 16; ++r) pmax = fmaxf(pmax, p1[r]);
  { auto rr = __builtin_amdgcn_permlane32_swap(__float_as_uint(pmax), __float_as_uint(pmax), false, false);
    pmax = fmaxf(__uint_as_float(rr[0]), __uint_as_float(rr[1])); }
  if (__builtin_expect(__all(pmax - m_reg <= THRZ), 1)) { alpha = 1.f; }
  else { const float mn = fmaxf(m_reg, pmax); alpha = __builtin_amdgcn_exp2f(m_reg - mn); m_reg = mn; shifted = true; }
  if (__builtin_expect(shifted, 0)) {
#pragma unroll
    for (int r = 0; r < 16; ++r) { p0[r] -= m_reg; p1[r] -= m_reg; } }
#pragma unroll
  for (int r = 0; r < 16; ++r) p0[r] = __builtin_amdgcn_exp2f(p0[r]);
}
__device__ __forceinline__ void partialSM_m(f32x16& p0, f32x16& p1, float& m_reg, float& alpha, bool first) {
  float pmax = p0[0];
#pragma unroll
  for (int r = 1; r < 16; ++r) pmax = fmaxf(pmax, p0[r]);
#pragma unroll
  for (int r = 0; r < 16; ++r) pmax = fmaxf(pmax, p1[r]);
  { auto rr = __builtin_amdgcn_permlane32_swap(__float_as_uint(pmax), __float_as_uint(pmax), false, false);
    pmax = fmaxf(__uint_as_float(rr[0]), __uint_as_float(rr[1])); }
  alpha = 1.f;
  if (first) m_reg = pmax;
  else if (!__all(pmax - m_reg <= THRZ)) { const float d = fmaxf(pmax - m_reg, 0.f); alpha = __builtin_amdgcn_exp2f(-d); m_reg += d; }
#pragma unroll
  for (int r = 0; r < 16; ++r) { p0[r] -= m_reg; p1[r] -= m_reg; }
#pragma unroll
  for (int r = 0; r < 16; ++r) p0[r] = __builtin_amdgcn_exp2f(p0[r]);
}
template <int OFF> __device__ __forceinline__ bf16x8 kread(int addr) { bf16x8 r; asm volatile("ds_read_b128 %0, %1 offset:%2" : "=&v"(r) : "v"(addr), "i"(OFF) : "memory"); return r; }
#define LGKM(N) asm volatile("s_waitcnt lgkmcnt(" #N ")" ::: "memory")
#define LGKMV(N, X) asm volatile("s_waitcnt lgkmcnt(" #N ")" : "+v"(X) :: "memory")
#define LGKMV4(N, A, B, C, D) asm volatile("s_waitcnt lgkmcnt(" #N ")" : "+v"(A), "+v"(B), "+v"(C), "+v"(D) :: "memory")
#define LGKMV2(N, A, B) asm volatile("s_waitcnt lgkmcnt(" #N ")" : "+v"(A), "+v"(B) :: "memory")
#define PIN1(A) asm volatile("" : "+v"(A))
#define PIN2(A, B) asm volatile("" : "+v"(A), "+v"(B))
#define PIN3(A, B, C) asm volatile("" : "+v"(A), "+v"(B), "+v"(C))
#define PIN4(A, B, C, D) asm volatile("" : "+v"(A), "+v"(B), "+v"(C), "+v"(D))
template <int K> __device__ __forceinline__ void k_rd(bf16x8& a, bf16x8& b, int blN, int blR) {
  if constexpr (K < 8) { const int ad = blN ^ (K << 5); a = kread<0>(ad); b = kread<8192>(ad); }
  else { const int ad = blR ^ ((K - 8) << 5); a = kread<0>(ad); b = kread<4096>(ad); }
}
template <int C, int VAR> __device__ __forceinline__ void fin_chunk(f32x16& p0, f32x16& p1, float alpha, float& l_reg, float& ps0, float& ps1, unsigned (&t)[4], bf16x8& pa0, bf16x8& pa1, bf16x8& pa2, bf16x8& pa3, float nm) {
  if constexpr (C >= 14 && C < 22) { p0[2 * (C - 14)] = nm; p0[2 * (C - 14) + 1] = nm; PIN2(p0[2 * (C - 14)], p0[2 * (C - 14) + 1]); }
  if constexpr (C < 8) { if constexpr (VAR & 8) { p1[2 * C] *= 1.0001f; p1[2 * C + 1] *= 1.0001f; } else { p1[2 * C] = __builtin_amdgcn_exp2f(p1[2 * C]); p1[2 * C + 1] = __builtin_amdgcn_exp2f(p1[2 * C + 1]); }
    if constexpr (C == 0) ps0 = p0[0] + p0[1]; else { ps0 += p0[2 * C]; ps0 += p0[2 * C + 1]; }
    PIN3(p1[2 * C], p1[2 * C + 1], ps0); }
  else if constexpr (C < 16) { constexpr int I = C - 8;
    if constexpr (I == 0) ps1 = p1[0] + p1[1]; else { ps1 += p1[2 * I]; ps1 += p1[2 * I + 1]; }
    if constexpr (I == 0) { t[0] = cvtpk(p0[0], p0[1]); t[1] = cvtpk(p0[2], p0[3]); }
    else if constexpr (I == 1) { t[2] = cvtpk(p0[4], p0[5]); t[3] = cvtpk(p0[6], p0[7]); }
    else if constexpr (I == 2) { auto r0 = __builtin_amdgcn_permlane32_swap(t[0], t[2], false, false); auto r1 = __builtin_amdgcn_permlane32_swap(t[1], t[3], false, false); u32x4 w = {r0[0], r1[0], r0[1], r1[1]}; PIN4(w.x, w.y, w.z, w.w); pa0 = __builtin_bit_cast(bf16x8, w); }
    else if constexpr (I == 3) { t[0] = cvtpk(p0[8], p0[9]); t[1] = cvtpk(p0[10], p0[11]); }
    else if constexpr (I == 4) { t[2] = cvtpk(p0[12], p0[13]); t[3] = cvtpk(p0[14], p0[15]); }
    else if constexpr (I == 5) { auto r0 = __builtin_amdgcn_permlane32_swap(t[0], t[2], false, false); auto r1 = __builtin_amdgcn_permlane32_swap(t[1], t[3], false, false); u32x4 w = {r0[0], r1[0], r0[1], r1[1]}; PIN4(w.x, w.y, w.z, w.w); pa1 = __builtin_bit_cast(bf16x8, w); }
    PIN1(ps1); }
  else if constexpr (C == 16) { float ps = ps0 + ps1; auto rr = __builtin_amdgcn_permlane32_swap(__float_as_uint(ps), __float_as_uint(ps), false, false); ps = __uint_as_float(rr[0]) + __uint_as_float(rr[1]); l_reg = l_reg * alpha + ps; PIN1(l_reg); }
  else if constexpr (C == 17) { t[0] = cvtpk(p1[0], p1[1]); t[1] = cvtpk(p1[2], p1[3]); }
  else if constexpr (C == 18) { t[2] = cvtpk(p1[4], p1[5]); t[3] = cvtpk(p1[6], p1[7]); }
  else if constexpr (C == 19) { auto r0 = __builtin_amdgcn_permlane32_swap(t[0], t[2], false, false); auto r1 = __builtin_amdgcn_permlane32_swap(t[1], t[3], false, false); u32x4 w = {r0[0], r1[0], r0[1], r1[1]}; PIN4(w.x, w.y, w.z, w.w); pa2 = __builtin_bit_cast(bf16x8, w); }
  else if constexpr (C == 20) { t[0] = cvtpk(p1[8], p1[9]); t[1] = cvtpk(p1[10], p1[11]); }
  else if constexpr (C == 21) { t[2] = cvtpk(p1[12], p1[13]); t[3] = cvtpk(p1[14], p1[15]); }
  else if constexpr (C == 22) { auto r0 = __builtin_amdgcn_permlane32_swap(t[0], t[2], false, false); auto r1 = __builtin_amdgcn_permlane32_swap(t[1], t[3], false, false); u32x4 w = {r0[0], r1[0], r0[1], r1[1]}; PIN4(w.x, w.y, w.z, w.w); pa3 = __builtin_bit_cast(bf16x8, w); }
}
template <int I> __device__ __forceinline__ bf16x8 kf_rd(int blN, int blR) {
  if constexpr (I < 16) return (I & 1) ? kread<8192>(blN ^ ((I >> 1) << 5)) : kread<0>(blN ^ ((I >> 1) << 5));
  else return (I & 1) ? kread<4096>(blR ^ (((I >> 1) - 8) << 5)) : kread<0>(blR ^ (((I >> 1) - 8) << 5));
}
template <int VAR, typename DmaF>
__device__ __forceinline__ void step_qk_fin(f32x16& c0, f32x16& c1, float m_reg, f32x16& p0, f32x16& p1, float alpha, float& l_reg, bf16x8& pa0, bf16x8& pa1, bf16x8& pa2, bf16x8& pa3,
                                            const bf16x8* qr, int blN, int blR, DmaF dma) {
  bf16x8 f[24]; float ps0 = 0.f, ps1 = 0.f; unsigned t[4] = {0u, 0u, 0u, 0u}; const float nm = -m_reg;
  SBAR(); f[0] = kf_rd<0>(blN, blR); f[1] = kf_rd<1>(blN, blR); f[2] = kf_rd<2>(blN, blR);
#define QK_ONE(I, WAITN) do { if constexpr ((I) + 3 < 24) f[((I) + 3) % 24] = kf_rd<((I) + 3 < 24 ? (I) + 3 : 0)>(blN, blR); if constexpr (!(VAR & 4)) LGKMV(WAITN, f[I]); SBAR(); \
    if constexpr (((I) & 1) == 0) c0 = __builtin_amdgcn_mfma_f32_32x32x16_bf16(f[I], qr[(I) >> 1], c0, 0, 0, 0); else c1 = __builtin_amdgcn_mfma_f32_32x32x16_bf16(f[I], qr[(I) >> 1], c1, 0, 0, 0); \
    if constexpr (!(VAR & 1)) fin_chunk<(I), VAR>(p0, p1, alpha, l_reg, ps0, ps1, t, pa0, pa1, pa2, pa3, nm); SBAR(); } while (0)
  QK_ONE(0, 3); QK_ONE(1, 3); QK_ONE(2, 3); QK_ONE(3, 3); QK_ONE(4, 3); QK_ONE(5, 3); QK_ONE(6, 3); QK_ONE(7, 3); QK_ONE(8, 3); QK_ONE(9, 3); QK_ONE(10, 3); QK_ONE(11, 3);
  dma(); SBAR();
  QK_ONE(12, 3); QK_ONE(13, 3); QK_ONE(14, 3); QK_ONE(15, 3); QK_ONE(16, 3); QK_ONE(17, 3); QK_ONE(18, 3); QK_ONE(19, 3); QK_ONE(20, 3); QK_ONE(21, 2); QK_ONE(22, 1); QK_ONE(23, 0);
#undef QK_ONE
}
template <int VAR>
__device__ __forceinline__ void step_pv_max(f32x16* o, int vb, bf16x8 pa0, bf16x8 pa1, bf16x8 pa2, bf16x8 pa3, f32x16& c0, f32x16& c1, float& m_reg, float& alpha, f32x16& n0, f32x16& n1) {
  s16x4 fl[4][4], fh[4][4]; float pm = 0.f, nm = -m_reg; alpha = 1.f;
#define PK(L, H) (bf16x8){L[0], L[1], L[2], L[3], H[0], H[1], H[2], H[3]}
#define RDF(KS, D) do { fl[KS][D] = tr_read<v_rd_off<4>(D, KS, 0)>(vb); fh[KS][D] = tr_read<v_rd_off<4>(D, KS, 1)>(vb); } while (0)
#define MX3(A, B) pm = fmaxf(fmaxf(pm, A), B)
#define PV_CHUNK(C) do { if constexpr (VAR & 2) break; \
    n1[C] = nm; PIN1(n1[C]); \
    if constexpr ((C) == 0) { pm = fmaxf(fmaxf(c0[0], c0[1]), c0[2]); MX3(c0[3], c0[4]); MX3(c0[5], c0[6]); PIN1(pm); } \
    else if constexpr ((C) == 1) { MX3(c0[7], c0[8]); MX3(c0[9], c0[10]); MX3(c0[11], c0[12]); PIN1(pm); } \
    else if constexpr ((C) == 2) { MX3(c0[13], c0[14]); MX3(c0[15], c1[0]); MX3(c1[1], c1[2]); PIN1(pm); } \
    else if constexpr ((C) == 3) { MX3(c1[3], c1[4]); MX3(c1[5], c1[6]); MX3(c1[7], c1[8]); PIN1(pm); } \
    else if constexpr ((C) == 4) { MX3(c1[9], c1[10]); MX3(c1[11], c1[12]); MX3(c1[13], c1[14]); PIN1(pm); } \
    else if constexpr ((C) == 5) { pm = fmaxf(pm, c1[15]); auto rr = __builtin_amdgcn_permlane32_swap(__float_as_uint(pm), __float_as_uint(pm), false, false); pm = fmaxf(__uint_as_float(rr[0]), __uint_as_float(rr[1])); PIN1(pm); } \
    else if constexpr ((C) >= 8 && (VAR & 8)) { c0[2 * ((C) - 8)] *= 1.0001f; c0[2 * ((C) - 8) + 1] *= 1.0001f; PIN2(c0[2 * ((C) - 8)], c0[2 * ((C) - 8) + 1]); } \
    else if constexpr ((C) >= 8) { c0[2 * ((C) - 8)] = __builtin_amdgcn_exp2f(c0[2 * ((C) - 8)]); c0[2 * ((C) - 8) + 1] = __builtin_amdgcn_exp2f(c0[2 * ((C) - 8) + 1]); PIN2(c0[2 * ((C) - 8)], c0[2 * ((C) - 8) + 1]); } } while (0)
#define PV_FIX() do { if (__builtin_expect(!__all(pm <= THRZ), 0)) { const float d = fmaxf(pm, 0.f); alpha = __builtin_amdgcn_exp2f(-d); m_reg += d; nm = -m_reg; \
      _Pragma("unroll") for (int r = 0; r < 16; ++r) { c0[r] -= d; c1[r] -= d; n0[r] = nm; n1[r] = nm; } } SBAR(); } while (0)
#define PV_ONE(KS, D, PA, WN) do { if constexpr ((KS) < 3) RDF(((KS) < 3 ? (KS) + 1 : 0), D); if constexpr (!(VAR & 4)) LGKMV2(WN, fl[KS][D], fh[KS][D]); SBAR(); \
    o[D] = __builtin_amdgcn_mfma_f32_32x32x16_bf16(PA, PK(fl[KS][D], fh[KS][D]), o[D], 0, 0, 0); PV_CHUNK(4 * (KS) + (D)); SBAR(); } while (0)
  SBAR(); RDF(0, 0); RDF(0, 1); RDF(0, 2); RDF(0, 3);
  PV_ONE(0, 0, pa0, 8); PV_ONE(0, 1, pa0, 8); PV_ONE(0, 2, pa0, 8); PV_ONE(0, 3, pa0, 8);
  PV_ONE(1, 0, pa1, 8); PV_ONE(1, 1, pa1, 8); PV_ONE(1, 2, pa1, 8); PV_ONE(1, 3, pa1, 8);
  PV_FIX();
  PV_ONE(2, 0, pa2, 8); PV_ONE(2, 1, pa2, 8); PV_ONE(2, 2, pa2, 8); PV_ONE(2, 3, pa2, 8);
  PV_ONE(3, 0, pa3, 6); PV_ONE(3, 1, pa3, 4); PV_ONE(3, 2, pa3, 2); PV_ONE(3, 3, pa3, 0);
#undef PV_ONE
#undef PV_FIX
#undef PV_CHUNK
#undef MX3
#undef RDF
#undef PK
}
constexpr int R3_V = 0, R3_KN = 3 * SHM_V, R3_KR = R3_KN + 3 * SHM_KN, R3_WS = R3_KR + 3 * SHM_KR, R3_QR = R3_WS + NWAVES * 256, MLA3_LDS = R3_QR + NWAVES * 4096;
template <int VAR>
__device__ __forceinline__ void mla_body2(const bf16* __restrict__ Qn, const bf16* __restrict__ Qr, const bf16* __restrict__ Kn, const bf16* __restrict__ Kr, const bf16* __restrict__ Vh,
                                          bf16* __restrict__ Ob, int ldo, int seq, char* lds, LAS unsigned char* ldsl) {
  int tid_ = mk_tid(); asm volatile("" : "+v"(tid_));
  const int tid = tid_, wid = __builtin_amdgcn_readfirstlane(tid >> 6), lane = tid & 63, r32 = lane & 31, hi = lane >> 5;
  char* V_lds = lds + R3_V; char* KN_lds = lds + R3_KN; char* KR_lds = lds + R3_KR;
  float* ws = (float*)(lds + R3_WS) + wid * 64; float* li_l = ws; float* al_l = ws + 32;
  float m_reg = 0.f, l_reg = 0; f32x16 o[4] = {}; bf16x8 qr[12];
  char* qrot = lds + R3_QR + wid * 4096 + lane * 16;
  { const bf16* Qw = Qn + (long)(wid * 32 + r32) * 1024 + hi * 8;
#pragma unroll
    for (int d0 = 0; d0 < 8; ++d0) qr[d0] = *reinterpret_cast<const bf16x8*>(Qw + d0 * 16);
    const bf16* Qw2 = Qr + (long)(wid * 32 + r32) * 512 + hi * 8;
#pragma unroll
    for (int d0 = 0; d0 < 4; ++d0) qr[8 + d0] = *reinterpret_cast<const bf16x8*>(Qw2 + d0 * 16); }
  unsigned offKN[2], offV[2], offKR;
#pragma unroll
  for (int i = 0; i < 2; ++i) { const int ch = wid + 8 * i;
    { const int row = ch * 4 + (lane >> 4), colB = ((lane & 15) << 4) ^ ((row & 15) << 4); offKN[i] = (unsigned)(row * 2048 + colB); }
    { const int sidx = ch * 2 + (lane >> 5), kk = (sidx >> 2) * 8 + ((lane & 31) >> 2), k = (kk & ~0xC) | ((kk & 4) << 1) | ((kk & 8) >> 1), c = (sidx & 3) * 32 + (lane & 3) * 8; offV[i] = (unsigned)(k * 2048 + c * 2); } }
  { const int row = wid * 8 + (lane >> 3), colB = ((lane & 7) << 4) ^ (((row >> 1) & 7) << 4); offKR = (unsigned)(row * 128 + colB); }
  const int vb0 = (int)(uintptr_t)V_lds + v_rd_base(lane);
#define DMA(slot, k0) do { const char* kn_ = (const char*)(Kn + (size_t)(k0) * 1024); const char* kr_ = (const char*)(Kr + (size_t)(k0) * 64); const char* vh_ = (const char*)(Vh + (size_t)(k0) * 1024); \
    __builtin_amdgcn_global_load_lds((const unsigned*)(kn_ + offKN[0]), (LAS unsigned*)(ldsl + R3_KN + (slot) * SHM_KN + wid * 1024), 16, 0, 0); \
    __builtin_amdgcn_global_load_lds((const unsigned*)(kn_ + offKN[1]), (LAS unsigned*)(ldsl + R3_KN + (slot) * SHM_KN + 8192 + wid * 1024), 16, 0, 0); \
    __builtin_amdgcn_global_load_lds((const unsigned*)(kr_ + offKR), (LAS unsigned*)(ldsl + R3_KR + (slot) * SHM_KR + wid * 1024), 16, 0, 0); \
    __builtin_amdgcn_global_load_lds((const unsigned*)(vh_ + offV[0]), (LAS unsigned*)(ldsl + R3_V + (slot) * SHM_V + wid * 1024), 16, 0, 0); \
    __builtin_amdgcn_global_load_lds((const unsigned*)(vh_ + offV[1]), (LAS unsigned*)(ldsl + R3_V + (slot) * SHM_V + 8192 + wid * 1024), 16, 0, 0); } while (0)
#define STEPBAR() asm volatile("s_waitcnt vmcnt(0) lgkmcnt(0)\n\ts_barrier" ::: "memory")
#define RESC(a) do { if (__any((a) < 1.f)) { if (hi == 0) al_l[r32] = (a); asm volatile("s_waitcnt lgkmcnt(0)" ::: "memory"); \
    _Pragma("unroll") for (int d = 0; d < 4; ++d) _Pragma("unroll") for (int r = 0; r < 16; ++r) o[d][r] *= al_l[crow(r, hi)]; } } while (0)
  f32x16 pA0, pA1, pB0, pB1; float mnA, mnB, alA, alB; bf16x8 pa0, pa1, pa2, pa3; const int NT = seq / 64;
  DMA(0, 0); DMA(1, 64); STEPBAR();
  qkt_mla_r(pA0, pA1, KN_lds, KR_lds, qr, r32, hi); partialSM_m(pA0, pA1, m_reg, alA, true);
  int sp = 0, sj = 1, sn = 2;
  const int blN0 = (int)(uintptr_t)KN_lds + r32 * 256 + ((hi ^ (r32 & 15)) << 4), blR0 = (int)(uintptr_t)KR_lds + r32 * 128 + ((hi ^ ((r32 >> 1) & 7)) << 4);
#define MLA_STEP(C0, C1, ALC, P0, P1, ALP, DMACOND, K0) do { \
    step_qk_fin<VAR>(C0, C1, m_reg, P0, P1, ALP, l_reg, pa0, pa1, pa2, pa3, qr, blN0 + sj * SHM_KN, blR0 + sj * SHM_KR, [&]() { if (DMACOND) DMA(sn, K0); }); \
    step_pv_max<VAR>(o, vb0 + sp * SHM_V, pa0, pa1, pa2, pa3, C0, C1, m_reg, ALC, P0, P1); \
    RESC(ALC); STEPBAR(); { const int t_ = sp; sp = sj; sj = sn; sn = t_; } } while (0)
  { const float nm = -m_reg;
#pragma unroll
    for (int r = 0; r < 16; ++r) { pB0[r] = nm; pB1[r] = nm; } }
  if (wid >= 4) __builtin_amdgcn_s_setprio(1);
#pragma unroll 1
  for (int j = 1; j + 1 < NT; j += 2) {
    MLA_STEP(pB0, pB1, alB, pA0, pA1, alA, true, (j + 1) * 64);
    MLA_STEP(pA0, pA1, alA, pB0, pB1, alB, j + 2 < NT, (j + 2) * 64);
  }
#undef MLA_STEP
  __builtin_amdgcn_s_setprio(0);
  int r32t = r32, hit = hi; asm volatile("" : "+v"(r32t), "+v"(hit));
  SBAR(); qkt_mla_r(pB0, pB1, KN_lds + sj * SHM_KN, KR_lds + sj * SHM_KR, qr, r32t, hit);
  finishSM(pA0, pA1, alA, l_reg, pa0, pa1, pa2, pa3); SBAR();
  pv_mla(o, vb0 + sp * SHM_V, pa0, pa1, pa2, pa3); partialSM_m(pB0, pB1, m_reg, alB, false);
  RESC(alB);
  finishSM(pB0, pB1, alB, l_reg, pa0, pa1, pa2, pa3); SBAR();
  pv_mla(o, vb0 + sj * SHM_V, pa0, pa1, pa2, pa3);
  if (hit == 0) li_l[r32t] = l_reg; asm volatile("s_waitcnt lgkmcnt(0)" ::: "memory");
  float rli[16];
#pragma unroll
  for (int r = 0; r < 16; ++r) rli[r] = __builtin_amdgcn_rcpf(li_l[crow(r, hit)]);
  bf16* Ow = Ob + (long)(wid * 32) * ldo;
#pragma unroll
  for (int r = 0; r < 16; ++r) { const int orow = crow(r, hit);
#pragma unroll
    for (int d0 = 0; d0 < 4; ++d0) Ow[(long)orow * ldo + d0 * 32 + r32t] = (bf16)(cvtpk(o[d0][r] * rli[r], 0.f) & 0xffffu); }
  __syncthreads();
#undef DMA
#undef STEPBAR
#undef RESC
}
}
namespace natt {
using att::bf16x8; using att::f32x16; using att::crow; using att::cvtpk;
constexpr int NA_V_BYTES = 8192, NA_K_BYTES = 8192;
constexpr int NA_OFF_RPB = NWAVES * (NA_V_BYTES + NA_K_BYTES);
constexpr int NA_OFF_WS = NA_OFF_RPB + 14912;
constexpr float LOG2E = 1.4426950408889634f;
#define NA_KSWZ(row, colB) ((row) * 128 + ((colB) ^ ((((row) >> 1) & 7) << 4)))
__device__ __forceinline__ void na_unit(const bf16* __restrict__ QKV, bf16* __restrict__ Y, const float* rpbS, char* lds, int unit, int wid, int lane) {
  const int qb = unit & 1, h = (unit >> 1) & 7, r = (unit >> 4) & 255, b = unit >> 12, r32 = lane & 31, hi = lane >> 5;
  int rs = r - 4; rs = rs < 0 ? 0 : (rs > 248 ? 248 : rs);
  char* Vw = lds + wid * (NA_V_BYTES + NA_K_BYTES); char* Kw = Vw + NA_V_BYTES; float* al_l = (float*)(lds + NA_OFF_WS) + wid * 64; float* li_l = al_l + 32;
  const int vb = (int)(uintptr_t)Vw + att::v_rd_base(lane);
  const long tok0 = (long)b * SEQ + (long)r * 64;
  bf16x8 qf[4];
#pragma unroll
  for (int d0 = 0; d0 < 4; ++d0) qf[d0] = *reinterpret_cast<const bf16x8*>(QKV + (tok0 + qb * 32 + r32) * 1536 + h * 64 + d0 * 16 + hi * 8);
  float m_reg = -1e30f, l_reg = 0.f; f32x16 o[2] = {};
  const int c = qb * 32 + r32; int cs = c - 8; cs = cs < 0 ? 0 : (cs > 48 ? 48 : cs);
  const int lk = lane >> 3, lc = lane & 7;
  bf16x8 kv[8], vv[8];
#define NA_LOAD(R_) do { const bf16* base_ = QKV + ((long)b * SEQ + (long)(R_) * 64 + lk) * 1536 + h * 64 + lc * 8; \
    _Pragma("unroll") for (int i = 0; i < 8; ++i) { kv[i] = *reinterpret_cast<const bf16x8*>(base_ + (long)(8 * i) * 1536 + 512); vv[i] = *reinterpret_cast<const bf16x8*>(base_ + (long)(8 * i) * 1536 + 1024); } } while (0)
  NA_LOAD(rs);
#pragma unroll 1
  for (int kr = 0; kr < 8; ++kr) { const int R = rs + kr;
#pragma unroll
    for (int i = 0; i < 8; ++i) { *(bf16x8*)(Kw + NA_KSWZ(lk + 8 * i, lc * 16)) = kv[i]; *(bf16x8*)(Vw + att::v_st<2>(lk + 8 * i, lc * 8)) = vv[i]; }
    asm volatile("s_waitcnt lgkmcnt(0)" ::: "memory");
    if (kr < 7) NA_LOAD(R + 1);
    const float* brow = rpbS + (h * 15 + (R - r + 7)) * 31;
    f32x16 p0 = {}, p1 = {};
#pragma unroll
    for (int d0 = 0; d0 < 4; ++d0) { const int cb = (d0 * 16 + hi * 8) * 2;
      const bf16x8 k0 = *reinterpret_cast<const bf16x8*>(Kw + NA_KSWZ(r32, cb)), k1 = *reinterpret_cast<const bf16x8*>(Kw + NA_KSWZ(32 + r32, cb));
      p0 = __builtin_amdgcn_mfma_f32_32x32x16_bf16(k0, qf[d0], p0, 0, 0, 0); p1 = __builtin_amdgcn_mfma_f32_32x32x16_bf16(k1, qf[d0], p1, 0, 0, 0); }
    float pmax = -1e30f;
#pragma unroll
    for (int rg = 0; rg < 16; ++rg) { const int j0 = crow(rg, hi), j1 = 32 + j0;
      const bool v0 = (j0 >= cs) && (j0 < cs + 16), v1 = (j1 >= cs) && (j1 < cs + 16);
      const float b0 = v0 ? brow[j0 - c + 15] : 0.f, b1 = v1 ? brow[j1 - c + 15] : 0.f;
      p0[rg] = v0 ? (p0[rg] * 0.125f + b0) * LOG2E : -1e30f; p1[rg] = v1 ? (p1[rg] * 0.125f + b1) * LOG2E : -1e30f;
      pmax = fmaxf(pmax, fmaxf(p0[rg], p1[rg])); }
    { auto rr = __builtin_amdgcn_permlane32_swap(__float_as_uint(pmax), __float_as_uint(pmax), false, false); pmax = fmaxf(__uint_as_float(rr[0]), __uint_as_float(rr[1])); }
    const float mn = fmaxf(m_reg, pmax), alpha = __builtin_amdgcn_exp2f(m_reg - mn); m_reg = mn;
    float ps = 0.f;
#pragma unroll
    for (int rg = 0; rg < 16; ++rg) { p0[rg] = __builtin_amdgcn_exp2f(p0[rg] - mn); p1[rg] = __builtin_amdgcn_exp2f(p1[rg] - mn); ps += p0[rg] + p1[rg]; }
    { auto rr = __builtin_amdgcn_permlane32_swap(__float_as_uint(ps), __float_as_uint(ps), false, false); ps = __uint_as_float(rr[0]) + __uint_as_float(rr[1]); }
    l_reg = l_reg * alpha + ps;
    bf16x8 pa0, pa1, pa2, pa3;
#define PK4(P, BASE, OUT) do { unsigned a0 = cvtpk(P[BASE + 0], P[BASE + 1]), a1 = cvtpk(P[BASE + 2], P[BASE + 3]);   \
    unsigned b0_ = cvtpk(P[BASE + 4], P[BASE + 5]), b1_ = cvtpk(P[BASE + 6], P[BASE + 7]);                              \
    auto r0 = __builtin_amdgcn_permlane32_swap(a0, b0_, false, false); auto r1 = __builtin_amdgcn_permlane32_swap(a1, b1_, false, false); \
    u32x4 w = {r0[0], r1[0], r0[1], r1[1]}; OUT = *reinterpret_cast<bf16x8*>(&w); } while (0)
    PK4(p0, 0, pa0); PK4(p0, 8, pa1); PK4(p1, 0, pa2); PK4(p1, 8, pa3);
#undef PK4
    if (hi == 0) al_l[r32] = alpha;
    asm volatile("s_waitcnt lgkmcnt(0)" ::: "memory");
#pragma unroll
    for (int d = 0; d < 2; ++d)
#pragma unroll
      for (int rg = 0; rg < 16; ++rg) o[d][rg] *= al_l[crow(rg, hi)];
    asm volatile("s_waitcnt lgkmcnt(0)" ::: "memory");
    att::pv_one<2, 0>(o[0], vb, pa0, pa1, pa2, pa3); att::pv_one<2, 1>(o[1], vb, pa0, pa1, pa2, pa3);
    asm volatile("s_waitcnt lgkmcnt(0)" ::: "memory");
  }
#undef NA_LOAD
  if (hi == 0) li_l[r32] = l_reg;
  asm volatile("s_waitcnt lgkmcnt(0)" ::: "memory");
  bf16* Ow = Y + (tok0 + qb * 32) * 1536 + h * 64;
#pragma unroll
  for (int rg = 0; rg < 16; ++rg) { const int orow = crow(rg, hi); const float rl = __builtin_amdgcn_rcpf(li_l[orow]);
#pragma unroll
    for (int d = 0; d < 2; ++d) Ow[(long)orow * 1536 + d * 32 + r32] = (bf16)(cvtpk(o[d][rg] * rl, 0.f) & 0xffffu); }
  asm volatile("s_waitcnt lgkmcnt(0)" ::: "memory");
}
#undef NA_KSWZ
}
namespace hfft {
constexpr int M = 16384;
__device__ __forceinline__ int pad(int i) { return i + (i >> 4); }
__device__ __forceinline__ f32x2 cadd(f32x2 a, f32x2 b) { return (f32x2){fadd_s(a.x, b.x), fadd_s(a.y, b.y)}; }
__device__ __forceinline__ f32x2 csub(f32x2 a, f32x2 b) { return (f32x2){fsub_s(a.x, b.x), fsub_s(a.y, b.y)}; }
__device__ __forceinline__ f32x2 cmul(f32x2 a, f32x2 b) { const float t0 = fmul_s(a.y, b.y), t1 = fmul_s(a.y, b.x); return (f32x2){ffnma_s(a.x, b.x, t0), ffma_s(a.x, b.y, t1)}; }
template <unsigned CXB, unsigned CYB, unsigned NCYB> __device__ __forceinline__ f32x2 cmul_lit(f32x2 a) {
  float re, im;
  asm("v_mul_f32_e32 %0, %1, %2" : "=v"(re) : "n"(CXB), "v"(a.x)); asm("v_fmac_f32_e32 %0, %1, %2" : "+v"(re) : "n"(NCYB), "v"(a.y));
  asm("v_mul_f32_e32 %0, %1, %2" : "=v"(im) : "n"(CYB), "v"(a.x)); asm("v_fmac_f32_e32 %0, %1, %2" : "+v"(im) : "n"(CXB), "v"(a.y));
  return (f32x2){re, im};
}
constexpr unsigned fbits(float f) { return __builtin_bit_cast(unsigned, f); }
__device__ constexpr float C32(int k) { return k == 0 ? 1.000000000e+00f : k == 1 ? 9.807852804e-01f : k == 2 ? 9.238795325e-01f : k == 3 ? 8.314696123e-01f : k == 4 ? 7.071067812e-01f : k == 5 ? 5.555702330e-01f : k == 6 ? 3.826834324e-01f : k == 7 ? 1.950903220e-01f : k == 8 ? 0.000000000e+00f : k == 9 ? -1.950903220e-01f : k == 10 ? -3.826834324e-01f : k == 11 ? -5.555702330e-01f : k == 12 ? -7.071067812e-01f : k == 13 ? -8.314696123e-01f : k == 14 ? -9.238795325e-01f : -9.807852804e-01f; }
__device__ constexpr float S32(int k) { return k == 0 ? 0.000000000e+00f : k == 1 ? 1.950903220e-01f : k == 2 ? 3.826834324e-01f : k == 3 ? 5.555702330e-01f : k == 4 ? 7.071067812e-01f : k == 5 ? 8.314696123e-01f : k == 6 ? 9.238795325e-01f : k == 7 ? 9.807852804e-01f : k == 8 ? 1.000000000e+00f : k == 9 ? 9.807852804e-01f : k == 10 ? 9.238795325e-01f : k == 11 ? 8.314696123e-01f : k == 12 ? 7.071067812e-01f : k == 13 ? 5.555702330e-01f : k == 14 ? 3.826834324e-01f : 1.950903220e-01f; }
template <int HL, int J> constexpr int el_off() { constexpr int HMIN = 1 << HL; return HL >= 4 ? J * (HMIN + (HMIN >> 4)) : HL == 2 ? 4 * J + (J >> 2) : J; }
template <int R, bool INV, int Q, int J> __device__ __forceinline__ void fft_bfly(f32x2 (&v)[1 << R], const f32x2 (&w)[R]) {
  constexpr int span = 1 << (R - 1 - Q);
  if constexpr ((J & span) == 0) { constexpr int jj = J & (span - 1), ci = jj * (16 / span);
    if constexpr (!INV) { f32x2 tw; if constexpr (ci == 0) tw = w[Q]; else tw = (f32x2){w[Q].x * C32(ci) + w[Q].y * S32(ci), w[Q].y * C32(ci) - w[Q].x * S32(ci)}; const f32x2 a = v[J], bq = v[J + span]; v[J] = cadd(a, bq); v[J + span] = cmul(csub(a, bq), tw); }
    else { f32x2 tw; if constexpr (ci == 0) tw = w[Q]; else tw = (f32x2){w[Q].x * C32(ci) - w[Q].y * S32(ci), w[Q].y * C32(ci) + w[Q].x * S32(ci)}; const f32x2 a = v[J], bq = cmul(v[J + span], tw); v[J] = cadd(a, bq); v[J + span] = csub(a, bq); } }
}
template <int R, bool INV, int Q, int... J> __device__ __forceinline__ void fft_stage(f32x2 (&v)[1 << R], const f32x2 (&w)[R], std::integer_sequence<int, J...>) { (fft_bfly<R, INV, Q, J>(v, w), ...); }
template <int R, bool INV, int... Q> __device__ __forceinline__ void fft_stages(f32x2 (&v)[1 << R], const f32x2 (&w)[R], std::integer_sequence<int, Q...>) {
  (fft_stage<R, INV, (INV ? R - 1 - Q : Q)>(v, w, std::make_integer_sequence<int, (1 << R)>{}), ...); }
template <int R, int HL, int... J> __device__ __forceinline__ void fft_ld(f32x2 (&v)[1 << R], const LAS f32x2* p, std::integer_sequence<int, J...>) { ((v[J] = p[el_off<HL, J>()]), ...); }
template <int R, int HL, int... J> __device__ __forceinline__ void fft_st(const f32x2 (&v)[1 << R], LAS f32x2* p, std::integer_sequence<int, J...>) { ((p[el_off<HL, J>()] = v[J]), ...); }
template <int R, int... Q> __device__ __forceinline__ void fft_tw(f32x2 (&w)[R], std::integer_sequence<int, Q...>) { ((Q > 0 ? (void)(w[Q] = cmul(w[Q > 0 ? Q - 1 : 0], w[Q > 0 ? Q - 1 : 0])) : (void)0), ...); }
template <int R, int HL, bool INV>
__device__ __forceinline__ void pass(LAS f32x2* zz, const LAS f32x2* TW, int tid) {
  constexpr int RAD = 1 << R, HMIN = 1 << HL, G = HMIN << R;
#pragma unroll 1
  for (int bf = tid; bf < (M >> R); bf += NTHR) {
    const int blk = bf >> HL, off = bf & (HMIN - 1), base = blk * G + off;
    LAS f32x2* p = zz + pad(base);
    f32x2 v[RAD]; fft_ld<R, HL>(v, p, std::make_integer_sequence<int, RAD>{});
    f32x2 w[R];
    w[0] = TW[off << (14 - HL - R)]; if (INV) w[0].y = -w[0].y;
    fft_tw<R>(w, std::make_integer_sequence<int, R>{});
    fft_stages<R, INV>(v, w, std::make_integer_sequence<int, R>{});
    fft_st<R, HL>(v, p, std::make_integer_sequence<int, RAD>{});
  }
}
__device__ __forceinline__ void fft_fwd(LAS f32x2* zz, const LAS f32x2* TW, int tid) {
  pass<5, 9, false>(zz, TW, tid); __syncthreads(); pass<5, 4, false>(zz, TW, tid); __syncthreads(); pass<4, 0, false>(zz, TW, tid); __syncthreads();
}
__device__ __forceinline__ void fft_inv(LAS f32x2* zz, const LAS f32x2* TW, int tid) {
  pass<4, 0, true>(zz, TW, tid); __syncthreads(); pass<5, 4, true>(zz, TW, tid); __syncthreads(); pass<5, 9, true>(zz, TW, tid); __syncthreads();
}
__device__ __forceinline__ void pair_of(int u, int& p, int& pp, int& k) { const int j = 31 - __clz(u); p = (2 << j) + (u - (1 << j)); pp = 3 * (2 << j) - 1 - p; k = (int)(__brev((unsigned)p) >> 18); }
__device__ __forceinline__ void mulstep(LAS f32x2* zz, const f32x2* __restrict__ Kp, const f32x2* __restrict__ TWP, int tid) {
  if (tid == 0) {
    const f32x2 z0 = zz[0], k0 = Kp[0]; const float y0 = (z0.x + z0.y) * k0.x, ym = (z0.x - z0.y) * k0.y; zz[0] = (f32x2){0.5f * (y0 + ym), 0.5f * (y0 - ym)};
    const f32x2 z1 = zz[1]; const f32x2 yq = cmul((f32x2){z1.x, -z1.y}, Kp[1]); zz[1] = (f32x2){yq.x, -yq.y};
  }
#pragma unroll 8
  for (int i = 0; i < 16; ++i) { int u = tid + NTHR * i; u = u == 0 ? 1 : u;
      int p, pp, k; pair_of(u, p, pp, k); const f32x2 W = TWP[u], Kk = Kp[p], Km = Kp[pp]; const int ip = pad(p), ipp = pad(pp);
      const f32x2 Z = zz[ip], Zp = zz[ipp];
      const f32x2 E2 = {fadd_s(Z.x, Zp.x), fsub_s(Z.y, Zp.y)}, O2 = {fadd_s(Z.y, Zp.y), fsub_s(Zp.x, Z.x)};
      const f32x2 WO = cmul(W, O2); const f32x2 Xk = cadd(E2, WO); const f32x2 Xm = {fsub_s(E2.x, WO.x), fsub_s(WO.y, E2.y)};
      const f32x2 Yk = cmul(Xk, Kk), Ym = cmul(Xm, Km);
      const f32x2 Ze = {fadd_s(Yk.x, Ym.x), fsub_s(Yk.y, Ym.y)}; const f32x2 Dd = {fsub_s(Yk.x, Ym.x), fadd_s(Yk.y, Ym.y)};
      const f32x2 Zo = cmul(Dd, (f32x2){W.x, -W.y});
      zz[ip] = (f32x2){fmul_s(0.25f, fsub_s(Ze.x, Zo.y)), fmul_s(0.25f, fadd_s(Ze.y, Zo.x))}; zz[ipp] = (f32x2){fmul_s(0.25f, fadd_s(Ze.x, Zo.y)), fmul_s(0.25f, fsub_s(Zo.x, Ze.y))};
  }
}
__device__ __forceinline__ void filter_unit(const float* __restrict__ KT, f32x2* __restrict__ KF, const f32x2* __restrict__ TWP, Frame& F, int unit) {
  const LAS f32x2* TWS = (const LAS f32x2*)(F.lds + LC_TWS);
  LAS f32x2* zz = (LAS f32x2*)F.lds; LAS float* red = (LAS float*)(F.lds + LC_TP);
  const float* fw = KT + (size_t)unit * SEQ; const float* bw = KT + (size_t)(1024 + unit) * SEQ; const int tid = F.tid;
  float l1 = 0.f;
#pragma unroll
  for (int i = 0; i < 4; ++i) { const int q = tid + NTHR * i;
    const f32x4 a0 = *(const f32x4*)(fw + 8 * q), a1 = *(const f32x4*)(fw + 8 * q + 4);
    const f32x4 c0 = *(const f32x4*)(bw + SEQ - 8 * q - 8), c1 = *(const f32x4*)(bw + SEQ - 8 * q - 4); const float e = q > 0 ? bw[SEQ - 8 * q] : 0.f;
    zz[pad(4 * q + 0)] = (f32x2){a0[0], a0[1]}; zz[pad(4 * q + 1)] = (f32x2){a0[2], a0[3]}; zz[pad(4 * q + 2)] = (f32x2){a1[0], a1[1]}; zz[pad(4 * q + 3)] = (f32x2){a1[2], a1[3]};
    zz[pad(8192 + 4 * q + 0)] = (f32x2){e, c1[3]}; zz[pad(8192 + 4 * q + 1)] = (f32x2){c1[2], c1[1]}; zz[pad(8192 + 4 * q + 2)] = (f32x2){c1[0], c0[3]}; zz[pad(8192 + 4 * q + 3)] = (f32x2){c0[2], c0[1]};
    l1 += (fabsf(a0[0]) + fabsf(a0[1])) + (fabsf(a0[2]) + fabsf(a0[3])) + (fabsf(a1[0]) + fabsf(a1[1])) + (fabsf(a1[2]) + fabsf(a1[3]));
    l1 += (q == 2047 ? 0.f : fabsf(c0[0])) + fabsf(c0[1]) + (fabsf(c0[2]) + fabsf(c0[3])) + (fabsf(c1[0]) + fabsf(c1[1])) + (fabsf(c1[2]) + fabsf(c1[3])); }
  l1 = wave_sum(l1, F.lane); if (F.lane == 0) red[F.wave] = l1;
  __syncthreads();
  float tot = 0.f;
#pragma unroll
  for (int w = 0; w < NWAVES; ++w) tot += red[w];
  const float sc = 1.0f / (tot * (float)M);
  fft_fwd(zz, TWS, tid);
  f32x2* Ko = KF + (size_t)unit * M;
  if (tid == 0) { const f32x2 z0 = zz[0], z1 = zz[1]; Ko[0] = (f32x2){(z0.x + z0.y) * sc, (z0.x - z0.y) * sc}; Ko[1] = (f32x2){z1.x * sc, -z1.y * sc}; }
#pragma unroll 8
  for (int i = 0; i < 16; ++i) { int u = tid + NTHR * i; u = u == 0 ? 1 : u;
      int p, pp, k; pair_of(u, p, pp, k); const f32x2 W = TWP[u]; const f32x2 Z = zz[pad(p)], Zp = zz[pad(pp)];
      const f32x2 E = {0.5f * (Z.x + Zp.x), 0.5f * (Z.y - Zp.y)}, O = {0.5f * (Z.y + Zp.y), -0.5f * (Z.x - Zp.x)};
      const f32x2 WO = cmul(W, O); Ko[p] = (f32x2){(E.x + WO.x) * sc, (E.y + WO.y) * sc}; Ko[pp] = (f32x2){(E.x - WO.x) * sc, -(E.y - WO.y) * sc}; }
  __syncthreads();
}
__device__ __forceinline__ void conv_oct(const bf16* __restrict__ u, int q, float w0, float w1, float w2, float cb, float (&o)[8]) {
  const u32x4 cur = *(const u32x4*)(u + 8 * q); const unsigned prv = q > 0 ? *(const unsigned*)(u + 8 * q - 2) : 0u; const unsigned nxt = q < 2047 ? *(const unsigned*)(u + 8 * q + 8) : 0u;
  float x[10]; x[0] = bfhi(prv); x[1] = bflo(cur.x); x[2] = bfhi(cur.x); x[3] = bflo(cur.y); x[4] = bfhi(cur.y); x[5] = bflo(cur.z); x[6] = bfhi(cur.z); x[7] = bflo(cur.w); x[8] = bfhi(cur.w); x[9] = bflo(nxt);
#pragma unroll
  for (int j = 0; j < 8; ++j) o[j] = w0 * x[j] + w1 * x[j + 1] + w2 * x[j + 2] + cb;
}
__device__ __forceinline__ void hyena_unit(const Args& a, int l, Frame& F, int unit) {
  LAS f32x2* zz = (LAS f32x2*)F.lds; const int tid = F.tid, b = unit >> 9, c = unit & 511;
  const bf16* UT = (const bf16*)(a.ws + WS_UT); const f32x2* KF = (const f32x2*)(a.ws + WS_KF); const f32x2* TW = (const f32x2*)(a.ws + WS_TWP); const LAS f32x2* TWS = (const LAS f32x2*)(F.lds + LC_TWS); bf16* YT = (bf16*)(a.ws + WS_YT);
  const bf16* uv = UT + ((size_t)b * 1536 + c) * SEQ; const bf16* ux1 = uv + (size_t)512 * SEQ; const bf16* ux2 = uv + (size_t)1024 * SEQ;
  const float* cw = a.in[I_CONVW] + l * 3 * 1536; const float* cbv = a.in[I_CONVB] + l * 1536; const float* hd = a.in[I_HD] + l * 1024;
  const float v0 = cw[c], v1 = cw[1536 + c], v2 = cw[3072 + c], vb = cbv[c];
  const float g0 = cw[512 + c], g1 = cw[1536 + 512 + c], g2 = cw[3072 + 512 + c], gb = cbv[512 + c];
  const float h0 = cw[1024 + c], h1 = cw[1536 + 1024 + c], h2 = cw[3072 + 1024 + c], hb = cbv[1024 + c];
  const float d0 = hd[c], d1 = hd[512 + c];
  float zf0 = 0.f; asm volatile("" : "+v"(zf0)); const f32x2 zero2 = {zf0, zf0};
#pragma unroll
  for (int i = 0; i < 4; ++i) { const int q = tid + NTHR * i; float x[8]; conv_oct(uv, q, v0, v1, v2, vb, x);
#pragma unroll
    for (int j = 0; j < 4; ++j) { zz[pad(4 * q + j)] = (f32x2){x[2 * j], x[2 * j + 1]}; zz[pad(8192 + 4 * q + j)] = zero2; } }
  __syncthreads();
#if defined(MK_PROBE_FFT2)
  fft_fwd(zz, TWS, tid); fft_inv(zz, TWS, tid);
  for (int i = tid; i < 17408; i += NTHR) { f32x2 t = zz[i]; t.x *= (1.0f / 16384.0f); t.y *= (1.0f / 16384.0f); zz[i] = t; }
  __syncthreads();
#endif
  fft_fwd(zz, TWS, tid); mulstep(zz, KF + (size_t)c * M, TW, tid); __syncthreads(); fft_inv(zz, TWS, tid);
  float* z1s = (float*)(a.ws + WS_MIX) + (size_t)F.bid * 16384;
#pragma unroll
  for (int i = 0; i < 4; ++i) { const int q = tid + NTHR * i; float x[8], g[8], z[8]; conv_oct(uv, q, v0, v1, v2, vb, x); conv_oct(ux1, q, g0, g1, g2, gb, g);
#pragma unroll
    for (int j = 0; j < 4; ++j) { const f32x2 y = zz[pad(4 * q + j)]; z[2 * j] = g[2 * j] * (y.x + x[2 * j] * d0); z[2 * j + 1] = g[2 * j + 1] * (y.y + x[2 * j + 1] * d0); }
    *(f32x4*)(z1s + 8 * q) = (f32x4){z[0], z[1], z[2], z[3]}; *(f32x4*)(z1s + 8 * q + 4) = (f32x4){z[4], z[5], z[6], z[7]};
#pragma unroll
    for (int j = 0; j < 4; ++j) { zz[pad(4 * q + j)] = (f32x2){z[2 * j], z[2 * j + 1]}; zz[pad(8192 + 4 * q + j)] = zero2; } }
  __syncthreads();
  fft_fwd(zz, TWS, tid); mulstep(zz, KF + (size_t)(512 + c) * M, TW, tid); __syncthreads(); fft_inv(zz, TWS, tid);
  bf16* yo = YT + ((size_t)b * 512 + c) * SEQ;
#pragma unroll
  for (int i = 0; i < 4; ++i) { const int q = tid + NTHR * i; float g[8], o[8]; conv_oct(ux2, q, h0, h1, h2, hb, g); const f32x4 za = *(const f32x4*)(z1s + 8 * q), zb = *(const f32x4*)(z1s + 8 * q + 4);
    const float z[8] = {za[0], za[1], za[2], za[3], zb[0], zb[1], zb[2], zb[3]};
#pragma unroll
    for (int j = 0; j < 4; ++j) { const f32x2 y = zz[pad(4 * q + j)]; o[2 * j] = g[2 * j] * (y.x + z[2 * j] * d1); o[2 * j + 1] = g[2 * j + 1] * (y.y + z[2 * j + 1] * d1); }
    u32x4 w; w.x = pk2(o[0], o[1]); w.y = pk2(o[2], o[3]); w.z = pk2(o[4], o[5]); w.w = pk2(o[6], o[7]); *(u32x4*)(yo + 8 * q) = w; }
  __syncthreads();
}
}
constexpr int NPH = 12, NPHASE = NPH * NLAYER;
#ifndef MK_PHM
#define MK_PHM 0x7FFF
#endif
#ifndef MLA_SDEPTH
#define MLA_SDEPTH 2
#endif
#ifndef MK_SINGLE
#define MK_SINGLE 1
#endif
#ifndef MK_PROBE_SUB
#define MK_PROBE_SUB 0x1010
#endif
#ifndef MK_MLA
#define MK_MLA 1
#endif
#ifndef MK_NA
#define MK_NA 1
#endif
#ifndef MK_HY
#define MK_HY 1
#endif
#ifndef MK_MOE
#define MK_MOE 1
#endif

#if defined(MK_SYNTH)
__device__ __forceinline__ void synth_probe(int iters, const unsigned char* gsrc, LAS unsigned char* ldsl) {
    typedef float f32x16_t __attribute__((ext_vector_type(16)));
    typedef short bf16x8_t __attribute__((ext_vector_type(8)));
    typedef short s16x4_t __attribute__((ext_vector_type(4)));
    f32x16_t c0, c1, c2, c3; bf16x8_t a, b; float t0, t1, t2, t3, t4, t5, t6, t7, y;
    asm volatile("v_mov_b32 %0, 0" : "=v"(y));
    asm volatile("" : "=v"(c0), "=v"(c1), "=v"(c2), "=v"(c3), "=v"(a), "=v"(b));
    asm volatile("" : "=v"(t0), "=v"(t1), "=v"(t2), "=v"(t3), "=v"(t4), "=v"(t5), "=v"(t6), "=v"(t7));
#define SM(C) asm volatile("v_mfma_f32_32x32x16_bf16 %0, %1, %2, %0" : "+v"(C) : "v"(a), "v"(b))
#define SMF(C, F) asm volatile("v_mfma_f32_32x32x16_bf16 %0, %1, %2, %0" : "+v"(C) : "v"(F), "v"(b))
#define SV(X) asm volatile("v_add_f32 %0, %0, %1" : "+v"(X) : "v"(y))
#define SE(X) asm volatile("v_exp_f32 %0, %0" : "+v"(X))
#define SV4() do { SV(t0); SV(t1); SV(t2); SV(t3); } while (0)
#define SV4b() do { SV(t4); SV(t5); SV(t6); SV(t7); } while (0)
#if MK_SYNTH >= 3
    int lane_; asm volatile("v_mbcnt_lo_u32_b32 %0, -1, 0\n\tv_mbcnt_hi_u32_b32 %0, -1, %0" : "=v"(lane_));
    const int r32 = lane_ & 31, hi = lane_ >> 5;
    const int blN = 49152 + r32 * 256 + ((hi ^ (r32 & 15)) << 4), blR = 98304 + r32 * 128 + ((hi ^ ((r32 >> 1) & 7)) << 4);
    const int vb = att::v_rd_base(lane_);
    unsigned wv_; asm volatile("s_mov_b32 %0, 0" : "=s"(wv_));
    const unsigned voff = (unsigned)lane_ * 16u;
#define KRD(F, AD, OFF) asm volatile("ds_read_b128 %0, %1 offset:%2" : "=&v"(F) : "v"(AD), "i"(OFF) : "memory")
#define TRD(F, OFF) asm volatile("ds_read_b64_tr_b16 %0, %1 offset:%2" : "=&v"(F) : "v"(vb), "i"(OFF) : "memory")
#define WT(N) asm volatile("s_waitcnt lgkmcnt(" #N ")" ::: "memory")
#define SMV(C, L, H) do { bf16x8_t f_ = (bf16x8_t){L[0], L[1], L[2], L[3], H[0], H[1], H[2], H[3]}; SMF(C, f_); } while (0)
#endif
#if MK_SYNTH == 5
    bf16x8_t ra0, ra1, ra2, ra3, rb0, rb1;
    { int ln_; asm volatile("v_mbcnt_lo_u32_b32 %0, -1, 0\n\tv_mbcnt_hi_u32_b32 %0, -1, %0" : "=v"(ln_));
      const unsigned* xs = (const unsigned*)gsrc + (size_t)ln_ * 64;
#define RLD(R, O) do { u32x4 w_; w_.x = (xs[O] >> 16) | (xs[O + 1] & 0xffff0000u); w_.y = (xs[O + 2] >> 16) | (xs[O + 3] & 0xffff0000u); w_.z = (xs[O + 4] >> 16) | (xs[O + 5] & 0xffff0000u); w_.w = (xs[O + 6] >> 16) | (xs[O + 7] & 0xffff0000u); R = __builtin_bit_cast(bf16x8_t, w_); asm volatile("" : "+v"(R)); } while (0)
      RLD(ra0, 0); RLD(ra1, 8); RLD(ra2, 16); RLD(ra3, 24); RLD(rb0, 32); RLD(rb1, 40); }
    { f32x16_t z_ = {}; c0 = z_; c1 = z_; c2 = z_; c3 = z_; asm volatile("" : "+v"(c0), "+v"(c1), "+v"(c2), "+v"(c3)); }
#define SMR(C, A, B) asm volatile("v_mfma_f32_32x32x16_bf16 %0, %1, %2, %0" : "+v"(C) : "v"(A), "v"(B))
#endif
#pragma unroll 1
    for (int it = 0; it < iters; ++it) {
#if MK_SYNTH == 1
#pragma unroll
        for (int i = 0; i < 10; ++i) { SM(c0); SV4(); SE(t4); SM(c1); SV4b(); SE(t0); SM(c2); SV4(); SE(t5); SM(c3); SV4b(); if (i < 2) SE(t1); }
#elif MK_SYNTH == 5
#pragma unroll
        for (int i = 0; i < 10; ++i) { SMR(c0, ra0, rb0); SV4(); SE(t4); SMR(c1, ra1, rb1); SV4b(); SE(t0); SMR(c2, ra2, rb0); SV4(); SE(t5); SMR(c3, ra3, rb1); SV4b(); if (i < 2) SE(t1); }
#elif MK_SYNTH == 2
#pragma unroll
        for (int i = 0; i < 6; ++i) { SM(c0); SM(c1); SM(c2); SM(c3); }
#pragma unroll
        for (int i = 0; i < 12; ++i) { SV4(); SV4b(); SE(t0); if (i < 4) SE(t4); }
#pragma unroll
        for (int i = 0; i < 4; ++i) { SM(c0); SM(c1); SM(c2); SM(c3); }
#pragma unroll
        for (int i = 0; i < 8; ++i) { SV4(); SV4b(); SE(t1); SE(t5); }
#else
        { bf16x8_t f0, f1, f2, f3;
#define AD(I) (((I) < 16 ? blN : blR) ^ ((((I) >> 1) & 7) << 5))
#define OF(I) (((I) & 1) ? ((I) < 16 ? 8192 : 4096) : 0)
          KRD(f0, AD(0), 0); KRD(f1, AD(1), 8192); KRD(f2, AD(2), 0);
#define S1(I, FN, FC, CC, WN, TAIL) do { if ((I) + 3 < 24) { if (((I) + 3) & 1) KRD(FN, AD((I) + 3), (((I) + 3) < 16 ? 8192 : 4096)); else KRD(FN, AD((I) + 3), 0); } WT(WN); SMF(CC, FC); TAIL; } while (0)
          S1(0, f3, f0, c0, 3, { SV4(); SE(t4); }); S1(1, f0, f1, c1, 3, { SV4b(); SE(t0); }); S1(2, f1, f2, c0, 3, { SV4(); SE(t5); }); S1(3, f2, f3, c1, 3, { SV4b(); SE(t1); });
          S1(4, f3, f0, c0, 3, { SV4(); SE(t4); }); S1(5, f0, f1, c1, 3, { SV4b(); SE(t0); }); S1(6, f1, f2, c0, 3, { SV4(); SE(t5); }); S1(7, f2, f3, c1, 3, { SV4b(); SE(t1); });
          S1(8, f3, f0, c0, 3, { SV4(); SE(t4); }); S1(9, f0, f1, c1, 3, { SV4b(); SE(t0); }); S1(10, f1, f2, c0, 3, { SV4(); SE(t5); }); S1(11, f2, f3, c1, 3, { SV4b(); SE(t1); });
#if MK_SYNTH == 4
          { const unsigned char* g_ = gsrc + (size_t)(it & 255) * 40960;
#pragma unroll
            for (int q = 0; q < 5; ++q) __builtin_amdgcn_global_load_lds((const unsigned*)(g_ + q * 8192 + voff), (LAS unsigned*)(ldsl + 110000 + q * 8192), 16, 0, 0); }
#endif
          S1(12, f3, f0, c0, 3, { SV4(); SE(t4); }); S1(13, f0, f1, c1, 3, { SV4b(); SE(t0); }); S1(14, f1, f2, c0, 3, { SV4(); SE(t5); }); S1(15, f2, f3, c1, 3, { SV4b(); SE(t1); });
          S1(16, f3, f0, c0, 3, { SV4(); }); S1(17, f0, f1, c1, 3, { SV4b(); }); S1(18, f1, f2, c0, 3, { SV4(); }); S1(19, f2, f3, c1, 3, { SV4b(); });
          S1(20, f3, f0, c0, 3, { SV4(); }); S1(21, f0, f1, c1, 2, { SV4b(); }); S1(22, f1, f2, c0, 1, { SV4(); }); S1(23, f2, f3, c1, 0, { SV4b(); });
          s16x4_t l0, h0, l1, h1, l2, h2, l3, h3;
#define RA(D) do { TRD(l0, (D) * 512); TRD(h0, (D) * 512 + 2048); TRD(l1, (D) * 512 + 4096); TRD(h1, (D) * 512 + 6144); } while (0)
#define RB(D) do { TRD(l2, (D) * 512 + 8192); TRD(h2, (D) * 512 + 10240); TRD(l3, (D) * 512 + 12288); TRD(h3, (D) * 512 + 14336); } while (0)
          RA(0); RB(0);
#define S2(D, WA, WB) do { WT(WA); SMV(c2, l0, h0); SV4(); SE(t4); SMV(c2, l1, h1); SV4b(); SE(t0); if ((D) < 3) RA((D) + 1); WT(WB); SMV(c3, l2, h2); SV4(); SE(t5); SMV(c3, l3, h3); SV4b(); SE(t1); if ((D) < 3) RB((D) + 1); } while (0)
          S2(0, 4, 4); S2(1, 4, 4); S2(2, 4, 4); S2(3, 4, 0);
        }
#endif
#if MK_SYNTH == 4
        asm volatile("s_waitcnt vmcnt(0)" ::: "memory");
#endif
        asm volatile("s_barrier" ::: "memory");
    }
    asm volatile("" :: "v"(c0), "v"(c1), "v"(c2), "v"(c3), "v"(t0), "v"(t1), "v"(t2), "v"(t3), "v"(t4), "v"(t5), "v"(t6), "v"(t7));
}
#endif
template <int PHM> __global__ void __launch_bounds__(NTHR, 2) mk_fwd(Args a_) {
    typedef const __attribute__((address_space(4))) Args* KArgs;
    KArgs ap0 = (KArgs)__builtin_amdgcn_kernarg_segment_ptr();
    extern __shared__ __attribute__((aligned(16))) unsigned char lds[];
#define MKFRAME() Frame F; { int t_ = mk_tid(); asm volatile("" : "+v"(t_)); F.lds = (LAS unsigned char*)lds; F.tid = t_; F.lane = t_ & 63; F.wave = __builtin_amdgcn_readfirstlane(t_ >> 6); \
      F.G = gridDim.x; F.bid = blockIdx.x; F.gw = F.bid * NWAVES + F.wave; F.NGW = F.G * NWAVES; }
    unsigned char* ws0 = ap0->ws;
    if (threadIdx.x < 4) ((LAS unsigned*)((LAS unsigned char*)lds + LC_BAR))[threadIdx.x] = 0u;
    if ((threadIdx.x & 63) == 0) ((LAS int*)((LAS unsigned char*)lds + LC_WID))[(unsigned)__builtin_amdgcn_s_getreg((5 << 11) | 4) & 63u] = (int)(threadIdx.x >> 6);
    __syncthreads();
    XcdBarrier bar; bar.bar = (unsigned*)(ws0 + WS_CTL) + CW_BAR; bar.x = 0; bar.st = nullptr;
    const int lo = ap0->ph_lo, hi = ap0->ph_hi;
    if (hi - lo > 1) bar = xcd_barrier_post((unsigned*)(ws0 + WS_CTL) + CW_BAR, (volatile LAS unsigned*)((LAS unsigned char*)lds + LC_BAR));
#define IN(k) (lo <= (k) && (k) < hi)
#if defined(MK_PROBE_BAR2)
#define SEAM(k) do { if (IN(k) && IN((k) + 1)) { xcd_barrier(bar); xcd_barrier(bar); xcd_barrier(bar); } } while (0)
#else
#define SEAM(k) do { if (IN(k) && IN((k) + 1)) xcd_barrier(bar); } while (0)
#endif
    for (int l = 0; l < NLAYER; ++l) {
        const int pb = l * NPH;
        #if defined(MK_SYNTH)
#if MK_SYNTH == 5
        if (l == 0 && IN(0)) synth_probe(1024, (const unsigned char*)ap0->in[I_X], (LAS unsigned char*)0);
#else
        if (l == 0 && IN(0)) synth_probe(1024, ap0->ws + WS_WGU, (LAS unsigned char*)0);
#endif
#endif
        if (((PHM >> 0) & 1) && IN(pb + 0)) { KArgs ap = ap0; asm volatile("" : "+s"(ap)); const Args& a = *(const Args*)ap; unsigned char* ws = ap->ws; MKFRAME(); ph_prologue(a, l, F); VM_WAIT(); __syncthreads(); }
        SEAM(pb + 0);
        if (((PHM >> 1) & 1) && IN(pb + 1)) { KArgs ap = ap0; asm volatile("" : "+s"(ap)); const Args& a = *(const Args*)ap; unsigned char* ws = ap->ws; MKFRAME();
            pg8::Gemm g{(const pg8::bf16_t*)(ws + WS_XB), (const pg8::bf16_t*)(ws + WS_WIN), T, 4096, DM}; pg8::StaticOrder S; S.init(T, 4096, F.G, F.bid);
            pg8::EpiProj E{(bf16*)(ws + WS_U), (bf16*)(ws + WS_QKV), (bf16*)(ws + WS_CQ), (bf16*)(ws + WS_CKV), (bf16*)(ws + WS_KR)};
            pg8::gemm_phase<pg8::EpiProj, pg8::StaticOrder, true, true>(F.lds, g, S, E);
        }
        SEAM(pb + 1);
        if (((PHM >> 2) & 1) && IN(pb + 2)) { KArgs ap = ap0; asm volatile("" : "+s"(ap)); const Args& a = *(const Args*)ap; unsigned char* ws = ap->ws; MKFRAME();
#if MK_HY
            { const f32x2* TWg = (const f32x2*)(ws + WS_TW); LAS f32x2* TWS = (LAS f32x2*)(F.lds + LC_TWS); for (int i = F.tid; i < 1024; i += NTHR) TWS[i] = TWg[2 * i]; __syncthreads(); }
            for (int u = F.bid; u < 1024; u += F.G) hfft::filter_unit((const float*)(ws + WS_KT), (f32x2*)(ws + WS_KF), (const f32x2*)(ws + WS_TWP), F, u);
#endif
            ph_postproj_waveitems(a, l, F); VM_WAIT(); __syncthreads();
        }
        SEAM(pb + 2);
        if (((PHM >> 3) & 1) && IN(pb + 3)) { KArgs ap = ap0; asm volatile("" : "+s"(ap)); const Args& a = *(const Args*)ap; unsigned char* ws = ap->ws; MKFRAME();
#ifndef P3_NOQ
            { pg8::Gemm g{(const pg8::bf16_t*)(ws + WS_CQ), (const pg8::bf16_t*)(ws + WS_WUQ), T, 1536, 512}; pg8::StaticOrder S; S.init(T, 1536, F.G, F.bid);
              const float* cosT = (const float*)(ws + WS_ROPE);
              pg8::EpiQ E{(bf16*)(ws + WS_QN), (bf16*)(ws + WS_QR), (const float*)(ws + WS_RQ), cosT, cosT + SEQ * 32, QSCALE, SEQ - 1};
              pg8::gemm_phase<pg8::EpiQ, pg8::StaticOrder, true, true>(F.lds, g, S, E); }
#endif
#ifndef P3_NOKV
            { pg8::Gemm g{(const pg8::bf16_t*)(ws + WS_CKV), (const pg8::bf16_t*)(ws + WS_WUKV), T, 2048, 256}; pg8::StaticOrder S; S.init(T, 2048, F.G, F.bid);
              pg8::EpiKV E{(bf16*)(ws + WS_KN), (bf16*)(ws + WS_V), (const float*)(ws + WS_RKV)};
              pg8::gemm_phase<pg8::EpiKV, pg8::StaticOrder, true, true>(F.lds, g, S, E); }
#endif
        }
        SEAM(pb + 3);
        if (((PHM >> 4) & 1) && IN(pb + 4)) { KArgs ap = ap0; asm volatile("" : "+s"(ap)); const Args& a = *(const Args*)ap; unsigned char* ws = ap->ws; MKFRAME();
#if MK_MLA
            if (PHM & 0x1000) for (int u = F.bid; u < 1024; u += F.G) { const int xq_ = ((u >> 8) << 5) + ((u & 255) >> 3), qb = xq_ & 63, h = u & 7, b = xq_ >> 6;     const size_t row0 = (size_t)b * SEQ + qb * 256, key0 = (size_t)b * SEQ;
                att::mla_body2<((PHM >> 16) & 15)>((const bf16*)(ws + WS_QN) + row0 * 1024 + h * 128, (const bf16*)(ws + WS_QR) + row0 * 512 + h * 64, (const bf16*)(ws + WS_KN) + key0 * 1024 + h * 128,
                                 (const bf16*)(ws + WS_KROT) + key0 * 64, (const bf16*)(ws + WS_V) + key0 * 1024 + h * 128, (bf16*)(ws + WS_Y) + row0 * 1536 + 512 + h * 128, 1536, SEQ, (char*)lds, F.lds); }
#else
            { u32x4* y = (u32x4*)(ws + WS_Y); const u32x4 z = {0u, 0u, 0u, 0u}; for (size_t i = (size_t)F.bid * NTHR + F.tid; i < (size_t)T * 128; i += (size_t)F.G * NTHR) { const size_t row = i >> 7, c = i & 127; y[row * 192 + 64 + c] = z; } }
#endif
#if MK_HY
            if (PHM & 0x2000) { { const f32x2* TWg = (const f32x2*)(ws + WS_TW); LAS f32x2* TWS = (LAS f32x2*)(F.lds + LC_TWS); for (int i = F.tid; i < 1024; i += NTHR) TWS[i] = TWg[2 * i]; __syncthreads(); }
              for (int u = F.bid; u < 1024; u += F.G) { const int rnd_ = u / F.G, cc_ = (u % F.G) + F.G * (rnd_ >> 1); hfft::hyena_unit(a, l, F, F.G == 256 ? ((rnd_ & 1) << 9) + cc_ : u); } }
#else
            { u32x4* y = (u32x4*)(ws + WS_YT); const u32x4 z = {0u, 0u, 0u, 0u}; for (size_t i = (size_t)F.bid * NTHR + F.tid; i < (size_t)2 * 512 * SEQ / 8; i += (size_t)F.G * NTHR) y[i] = z; }
#endif
#if MK_NA
            if (PHM & 0x4000) { float* rpbS = (float*)(lds + natt::NA_OFF_RPB); const float* rpb = a.in[I_RPB] + l * 8 * 15 * 31;
              for (int i = F.tid; i < 8 * 15 * 31; i += NTHR) rpbS[i] = rpb[i];
              __syncthreads();
              { unsigned* nac = (unsigned*)(ws + WS_CTL) + 32768 + l * 32; int u = F.gw; unsigned nxt = 0u;
                while (u < 2 * 256 * 8 * 2) {
                    if (F.lane == 0) nxt = __hip_atomic_fetch_add(nac, 1u, __ATOMIC_RELAXED, __HIP_MEMORY_SCOPE_AGENT);
                    natt::na_unit((const bf16*)(ws + WS_QKV), (bf16*)(ws + WS_Y), rpbS, (char*)lds, u, F.wave, F.lane);
                    u = F.NGW + (int)__builtin_amdgcn_readfirstlane(nxt); } }
              __syncthreads(); }
#else
            { u32x4* y = (u32x4*)(ws + WS_Y); const u32x4 z = {0u, 0u, 0u, 0u}; for (size_t i = (size_t)F.bid * NTHR + F.tid; i < (size_t)T * 64; i += (size_t)F.G * NTHR) { const size_t row = i >> 6, c = i & 63; y[row * 192 + c] = z; } }
#endif
            VM_WAIT(); __syncthreads();
        }
        SEAM(pb + 4);
        if (((PHM >> 5) & 1) && IN(pb + 5)) { KArgs ap = ap0; asm volatile("" : "+s"(ap)); const Args& a = *(const Args*)ap; unsigned char* ws = ap->ws; MKFRAME(); ph_groupnorm(a, F); VM_WAIT(); __syncthreads(); }
        SEAM(pb + 5);
        if (((PHM >> 6) & 1) && IN(pb + 6)) { KArgs ap = ap0; asm volatile("" : "+s"(ap)); const Args& a = *(const Args*)ap; unsigned char* ws = ap->ws; MKFRAME();
            pg8::Gemm g{(const pg8::bf16_t*)(ws + WS_MIX), (const pg8::bf16_t*)(ws + WS_WOUT), T, DM, DM}; pg8::StaticOrder S; S.init(T, DM, F.G, F.bid);
            pg8::EpiOut E{(const pg8::bf16_t*)(ws + WS_XB), (pg8::bf16_t*)(ws + WS_H1), (f32x2*)(ws + WS_PART), ALPHA};
            pg8::gemm_phase<pg8::EpiOut, pg8::StaticOrder, true, true>(F.lds, g, S, E);
        }
        SEAM(pb + 6);
        if (((PHM >> 7) & 1) && IN(pb + 7)) { KArgs ap = ap0; asm volatile("" : "+s"(ap)); const Args& a = *(const Args*)ap; unsigned char* ws = ap->ws; MKFRAME(); ph_router(a, l, F);
#if defined(MK_PROBE_ROUTER2)
            __syncthreads(); ph_router(a, l, F, 1);
#endif
            VM_WAIT(); __syncthreads(); }
        SEAM(pb + 7);
        if (((PHM >> 9) & 1) && IN(pb + 9)) { KArgs ap = ap0; asm volatile("" : "+s"(ap)); const Args& a = *(const Args*)ap; unsigned char* ws = ap->ws; MKFRAME();
            moe_tables(a, l, F);
            const LAS int* tp = (const LAS int*)(F.lds + LC_TP); const int ntiles = tp[64];
            pg8::Gemm g{(const pg8::bf16_t*)(ws + WS_XM), (const pg8::bf16_t*)(ws + WS_WGU), ntiles * 256, 1024, DM};
            pg8::MoeOrder S{(const LAS int*)(F.lds + LC_TILEE), ntiles, 4, F.G, F.bid, (const pg8::u32x2*)(ws + WS_TABE), tp, (const LAS int*)(F.lds + LC_CNT)};
            pg8::EpiGU E{(bf16*)(ws + WS_HH)};
            pg8::gemm_phase_g<pg8::EpiGU, pg8::MoeOrder, true, true>(F.lds, g, S, E);
        }
        SEAM(pb + 9);
        if (((PHM >> 10) & 1) && IN(pb + 10)) { KArgs ap = ap0; asm volatile("" : "+s"(ap)); const Args& a = *(const Args*)ap; unsigned char* ws = ap->ws; MKFRAME();
            moe_tables(a, l, F);
            const LAS int* tp = (const LAS int*)(F.lds + LC_TP); const int ntiles = tp[64];
            pg8::Gemm g{(const pg8::bf16_t*)(ws + WS_HH), (const pg8::bf16_t*)(ws + WS_WDN), ntiles * 256, 2048, 512};
            pg8::MoeOrder S{(const LAS int*)(F.lds + LC_TILEE), ntiles, 8, F.G, F.bid, (const pg8::u32x2*)(ws + WS_TABE), tp, (const LAS int*)(F.lds + LC_CNT)};
            pg8::EpiDown E{(bf16*)(ws + WS_FF), (const pg8::u32x2*)(ws + WS_TABE), tp, (const LAS int*)(F.lds + LC_CNT)};
            pg8::gemm_phase<pg8::EpiDown, pg8::MoeOrder, true, true>(F.lds, g, S, E);
        }
        SEAM(pb + 10);
        if (((PHM >> 11) & 1) && IN(pb + 11)) { KArgs ap = ap0; asm volatile("" : "+s"(ap)); const Args& a = *(const Args*)ap; unsigned char* ws = ap->ws; MKFRAME(); ph_combine(a, l, F); VM_WAIT(); __syncthreads(); }
        SEAM(pb + 11);
    }
#undef IN
#undef SEAM
}

extern "C" void kernel_launch(void* const* d_in, const int* in_sizes, int n_in, void* d_out, int out_size, void* d_ws, size_t ws_size, hipStream_t stream) {
    static int grid = 0;
    if (grid == 0) {
        if (n_in != 28 || out_size != T * DM || ws_size < WS_END) { fprintf(stderr, "kernel_launch: unexpected shapes (n_in %d, out %d, ws %zu)\n", n_in, out_size, ws_size); grid = -1; return; }
        int dev = 0, cus = 0, per_cu = 0;
        if (hipGetDevice(&dev) != hipSuccess || hipDeviceGetAttribute(&cus, hipDeviceAttributeMultiprocessorCount, dev) != hipSuccess) { grid = -1; return; }
#if defined(MK_PROBE_DUP)
        const void* fns[2] = {(const void*)mk_fwd<MK_PHM>, (const void*)mk_fwd<MK_PROBE_SUB>}; const int nfn = 2;
#else
        const void* fns[1] = {(const void*)mk_fwd<MK_PHM>}; const int nfn = 1;
#endif
        for (int i = 0; i < nfn; ++i) if (hipFuncSetAttribute(fns[i], hipFuncAttributeMaxDynamicSharedMemorySize, LDS_BYTES) != hipSuccess) { fprintf(stderr, "kernel_launch: hipFuncSetAttribute failed\n"); grid = -1; return; }
        if (hipOccupancyMaxActiveBlocksPerMultiprocessor(&per_cu, fns[0], NTHR, LDS_BYTES) != hipSuccess || per_cu < 1) fprintf(stderr, "kernel_launch: occupancy query says %d\n", per_cu);
        (void)hipGetLastError();
        grid = cus;
    }
    if (grid < 0) return;
    if (hipMemsetAsync((char*)d_ws + WS_CTL, 0, CTL_ZERO_BYTES, stream) != hipSuccess) return;
    Args a{};
    for (int i = 0; i < 28; ++i) a.in[i] = (const float*)d_in[i];
    a.out = (float*)d_out; a.ws = (unsigned char*)d_ws;
#if defined(MK_PROBE_DUP)
    for (int p = 0; p < NPHASE; ++p) { a.ph_lo = p; a.ph_hi = p + 1; const int k = p % NPH;
#if defined(MK_PROBE_PRE)
        if (((MK_PROBE_DUP >> k) & 1) && k == 4 && p < NPH) hipLaunchKernelGGL(mk_fwd<MK_PROBE_SUB>, dim3(grid), dim3(NTHR), LDS_BYTES, stream, a);
        hipLaunchKernelGGL(mk_fwd<MK_PHM>, dim3(grid), dim3(NTHR), LDS_BYTES, stream, a); continue;
#endif
        hipLaunchKernelGGL(mk_fwd<MK_PHM>, dim3(grid), dim3(NTHR), LDS_BYTES, stream, a);
        if ((MK_PROBE_DUP >> k) & 1) { if (k == 4) hipLaunchKernelGGL(mk_fwd<MK_PROBE_SUB>, dim3(grid), dim3(NTHR), LDS_BYTES, stream, a); else hipLaunchKernelGGL(mk_fwd<MK_PHM>, dim3(grid), dim3(NTHR), LDS_BYTES, stream, a); } }
#elif MK_SINGLE
    a.ph_lo = 0; a.ph_hi = NPHASE;
    hipLaunchKernelGGL(mk_fwd<MK_PHM>, dim3(grid), dim3(NTHR), LDS_BYTES, stream, a);
#else
    for (int p = 0; p < NPHASE; ++p) { a.ph_lo = p; a.ph_hi = p + 1; hipLaunchKernelGGL(mk_fwd<MK_PHM>, dim3(grid), dim3(NTHR), LDS_BYTES, stream, a); }
#endif
}
```
